# Optimizing an MI355X kernel written in HIP

```python
import jax, jax.numpy as jnp
from jax import lax
import numpy as np

D_MODEL = 1024
BATCH = 8
SEQ = 4096
DEPTH = 2

CHUNK = 64
Q_BLOCK = 128
HEAD_DIM = 64
CONV_WIDTH = D_MODEL // 2
LRU_WIDTH = D_MODEL // 2
CONV_GROUPS = CONV_WIDTH // HEAD_DIM
LRU_HEADS = LRU_WIDTH // HEAD_DIM
SHORT_CONV_K = 3
LRU_CONV_K = 4
RG_C = 8.0
SB_HEADS = D_MODEL // HEAD_DIM
D_FF = ((8 * D_MODEL // 3 + 255) // 256) * 256
N_MOD = 6
EPS = 1e-6

kernel_name = 'hybrid_shortconv_rglru_stickbreaking_adaln'


def rms_norm(x, g):
    x32 = x.astype(jnp.float32)
    y = x32 * lax.rsqrt(jnp.mean(x32 * x32, axis=-1, keepdims=True) + EPS)
    return (y * g.astype(jnp.float32)).astype(x.dtype)


def ada_modulation(c, ada_w, ada_b):
    m = jax.nn.silu(c) @ ada_w + ada_b
    return jnp.split(m, N_MOD, axis=-1)


def modulate(h, shift, scale):
    return h * (1.0 + scale[:, None, :]) + shift[:, None, :]


def causal_depthwise_conv(x, w):
    k_width = w.shape[0]
    seq = x.shape[1]
    xp = jnp.pad(x, ((0, 0), (k_width - 1, 0), (0, 0)))
    y = xp[:, 0:seq] * w[0]
    for k in range(1, k_width):
        y = y + xp[:, k:k + seq] * w[k]
    return y


def rg_lru(xr, w_a, b_a, w_x, b_x, lam):
    bsz, seq, width = xr.shape
    n_blk, blk = w_a.shape[0], w_a.shape[1]
    x32 = xr.astype(jnp.float32)
    xh = x32.reshape(bsz, seq, n_blk, blk)
    r = jax.nn.sigmoid(jnp.einsum('bshi,hij->bshj', xh, w_a.astype(jnp.float32)) + b_a).reshape(bsz, seq, width)
    i = jax.nn.sigmoid(jnp.einsum('bshi,hij->bshj', xh, w_x.astype(jnp.float32)) + b_x).reshape(bsz, seq, width)
    log_a = -RG_C * r * jax.nn.softplus(-lam.astype(jnp.float32))
    a = jnp.exp(log_a)
    b = jnp.sqrt(-jnp.expm1(2.0 * log_a)) * (i * x32)
    n_chunks = seq // CHUNK
    a_c = a.reshape(bsz, n_chunks, CHUNK, width).transpose(1, 0, 2, 3)
    b_c = b.reshape(bsz, n_chunks, CHUNK, width).transpose(1, 0, 2, 3)

    def combine(lhs, rhs):
        al, bl = lhs
        ar, br = rhs
        return al * ar, ar * bl + br

    def chunk_step(h0, ab):
        a_k, b_k = ab
        a_cum, b_cum = lax.associative_scan(combine, (a_k, b_k), axis=1)
        h = a_cum * h0[:, None, :] + b_cum
        return h[:, -1], h

    h_init = jnp.zeros((bsz, width), jnp.float32)
    _, hs = lax.scan(chunk_step, h_init, (a_c, b_c))
    return hs.transpose(1, 0, 2, 3).reshape(bsz, seq, width)


def stick_breaking_attention(q, k, v):
    seq, dh = q.shape[2], q.shape[3]
    scale = dh ** -0.5
    outs = []
    for blk in range(seq // Q_BLOCK):
        q0, q1 = blk * Q_BLOCK, (blk + 1) * Q_BLOCK
        qb = q[:, :, q0:q1].astype(jnp.float32)
        kb = k[:, :, :q1].astype(jnp.float32)
        vb = v[:, :, :q1].astype(jnp.float32)
        z = jnp.einsum('bhqd,bhkd->bhqk', qb, kb) * scale
        q_pos = jnp.arange(q0, q1)[:, None]
        k_pos = jnp.arange(q1)[None, :]
        strict = k_pos < q_pos
        log_keep = jnp.where(strict, jax.nn.log_sigmoid(-z), 0.0)
        prefix = jnp.cumsum(log_keep, axis=-1)
        after = prefix[..., -1:] - prefix
        w = jnp.where(strict, jnp.exp(jax.nn.log_sigmoid(z) + after), 0.0)
        outs.append(jnp.einsum('bhqk,bhkd->bhqd', w, vb))
    return jnp.concatenate(outs, axis=2)


def swiglu(h, w_gate, w_up, w_down):
    return (jax.nn.silu(h @ w_gate) * (h @ w_up)) @ w_down


def even_layer(x, c, ada_w, ada_b, mix_norm, w_in, conv_a_w, conv_b_w, conv_b_b,
               rg_a_w, rg_a_b, rg_x_w, rg_x_b, rg_lambda, w_out,
               ffn_norm, ffn_w_gate, ffn_w_up, ffn_w_down):
    sh_m, sc_m, g_m, sh_f, sc_f, g_f = ada_modulation(c, ada_w, ada_b)
    h = modulate(rms_norm(x, mix_norm), sh_m, sc_m)
    u = h @ w_in
    cuts = [CONV_WIDTH, 2 * CONV_WIDTH, 3 * CONV_WIDTH, 3 * CONV_WIDTH + LRU_WIDTH]
    a_b, a_c, a_x, r_gate, r_x = jnp.split(u, cuts, axis=-1)
    y_a = a_b * causal_depthwise_conv(a_c * a_x, conv_a_w)
    xr = causal_depthwise_conv(r_x, conv_b_w) + conv_b_b
    y_b = jax.nn.gelu(r_gate) * rg_lru(xr, rg_a_w, rg_a_b, rg_x_w, rg_x_b, rg_lambda).astype(x.dtype)
    y = jnp.concatenate([y_a, y_b], axis=-1) @ w_out
    x = x + g_m[:, None, :] * y
    hf = modulate(rms_norm(x, ffn_norm), sh_f, sc_f)
    return x + g_f[:, None, :] * swiglu(hf, ffn_w_gate, ffn_w_up, ffn_w_down)


def odd_layer(x, c, ada_w, ada_b, mix_norm, w_qkv, q_norm, k_norm, w_out,
              ffn_norm, ffn_w_gate, ffn_w_up, ffn_w_down):
    sh_m, sc_m, g_m, sh_f, sc_f, g_f = ada_modulation(c, ada_w, ada_b)
    h = modulate(rms_norm(x, mix_norm), sh_m, sc_m)
    bsz, seq, _ = x.shape
    qkv = (h @ w_qkv).reshape(bsz, seq, 3, SB_HEADS, HEAD_DIM)
    q = rms_norm(qkv[:, :, 0], q_norm).transpose(0, 2, 1, 3)
    k = rms_norm(qkv[:, :, 1], k_norm).transpose(0, 2, 1, 3)
    v = qkv[:, :, 2].transpose(0, 2, 1, 3)
    o = stick_breaking_attention(q, k, v).astype(x.dtype)
    o = o.transpose(0, 2, 1, 3).reshape(bsz, seq, SB_HEADS * HEAD_DIM)
    x = x + g_m[:, None, :] * (o @ w_out)
    hf = modulate(rms_norm(x, ffn_norm), sh_f, sc_f)
    return x + g_f[:, None, :] * swiglu(hf, ffn_w_gate, ffn_w_up, ffn_w_down)


def setup_inputs(seed: int = 0) -> dict:
    key = jax.random.key(seed)
    ks = jax.random.split(key, 40)
    f32 = jnp.float32

    def nrm(k, shape, scale):
        return jax.random.normal(k, shape, f32) * scale

    d = D_MODEL
    u = jax.random.uniform(ks[12], (LRU_WIDTH,), f32, 0.9, 0.999)
    a0 = u ** (1.0 / RG_C)
    lam = jnp.log(a0) - jnp.log1p(-a0)
    return {
        'x': nrm(ks[0], (BATCH, SEQ, d), 1.0),
        'c': nrm(ks[1], (BATCH, d), 1.0),
        'l0_ada_w': nrm(ks[2], (d, N_MOD * d), 0.5 * d ** -0.5),
        'l0_ada_b': nrm(ks[3], (N_MOD * d,), 0.02),
        'l0_mix_norm': 1.0 + nrm(ks[4], (d,), 0.02),
        'l0_w_in': nrm(ks[5], (d, 3 * CONV_WIDTH + 2 * LRU_WIDTH), d ** -0.5),
        'l0_conv_a_w': nrm(ks[6], (SHORT_CONV_K, CONV_WIDTH), SHORT_CONV_K ** -0.5),
        'l0_conv_b_w': nrm(ks[7], (LRU_CONV_K, LRU_WIDTH), LRU_CONV_K ** -0.5),
        'l0_conv_b_b': nrm(ks[8], (LRU_WIDTH,), 0.01),
        'l0_rg_a_w': nrm(ks[9], (LRU_HEADS, HEAD_DIM, HEAD_DIM), HEAD_DIM ** -0.5),
        'l0_rg_a_b': nrm(ks[10], (LRU_HEADS, HEAD_DIM), 0.01),
        'l0_rg_x_w': nrm(ks[11], (LRU_HEADS, HEAD_DIM, HEAD_DIM), HEAD_DIM ** -0.5),
        'l0_rg_x_b': nrm(ks[13], (LRU_HEADS, HEAD_DIM), 0.01),
        'l0_rg_lambda': lam,
        'l0_w_out': nrm(ks[14], (CONV_WIDTH + LRU_WIDTH, d), (CONV_WIDTH + LRU_WIDTH) ** -0.5),
        'l0_ffn_norm': 1.0 + nrm(ks[15], (d,), 0.02),
        'l0_ffn_w_gate': nrm(ks[16], (d, D_FF), d ** -0.5),
        'l0_ffn_w_up': nrm(ks[17], (d, D_FF), d ** -0.5),
        'l0_ffn_w_down': nrm(ks[18], (D_FF, d), D_FF ** -0.5),
        'l1_ada_w': nrm(ks[19], (d, N_MOD * d), 0.5 * d ** -0.5),
        'l1_ada_b': nrm(ks[20], (N_MOD * d,), 0.02),
        'l1_mix_norm': 1.0 + nrm(ks[21], (d,), 0.02),
        'l1_w_qkv': nrm(ks[22], (d, 3 * SB_HEADS * HEAD_DIM), d ** -0.5),
        'l1_q_norm': 1.0 + nrm(ks[23], (HEAD_DIM,), 0.02),
        'l1_k_norm': 1.0 + nrm(ks[24], (HEAD_DIM,), 0.02),
        'l1_w_out': nrm(ks[25], (SB_HEADS * HEAD_DIM, d), (SB_HEADS * HEAD_DIM) ** -0.5),
        'l1_ffn_norm': 1.0 + nrm(ks[26], (d,), 0.02),
        'l1_ffn_w_gate': nrm(ks[27], (d, D_FF), d ** -0.5),
        'l1_ffn_w_up': nrm(ks[28], (d, D_FF), d ** -0.5),
        'l1_ffn_w_down': nrm(ks[29], (D_FF, d), D_FF ** -0.5),
    }


def reference(x, c,
              l0_ada_w, l0_ada_b, l0_mix_norm, l0_w_in, l0_conv_a_w, l0_conv_b_w, l0_conv_b_b,
              l0_rg_a_w, l0_rg_a_b, l0_rg_x_w, l0_rg_x_b, l0_rg_lambda, l0_w_out,
              l0_ffn_norm, l0_ffn_w_gate, l0_ffn_w_up, l0_ffn_w_down,
              l1_ada_w, l1_ada_b, l1_mix_norm, l1_w_qkv, l1_q_norm, l1_k_norm, l1_w_out,
              l1_ffn_norm, l1_ffn_w_gate, l1_ffn_w_up, l1_ffn_w_down):
    even_params = [(l0_ada_w, l0_ada_b, l0_mix_norm, l0_w_in, l0_conv_a_w, l0_conv_b_w, l0_conv_b_b,
                    l0_rg_a_w, l0_rg_a_b, l0_rg_x_w, l0_rg_x_b, l0_rg_lambda, l0_w_out,
                    l0_ffn_norm, l0_ffn_w_gate, l0_ffn_w_up, l0_ffn_w_down)]
    odd_params = [(l1_ada_w, l1_ada_b, l1_mix_norm, l1_w_qkv, l1_q_norm, l1_k_norm, l1_w_out,
                   l1_ffn_norm, l1_ffn_w_gate, l1_ffn_w_up, l1_ffn_w_down)]
    for layer in range(DEPTH):
        if layer % 2 == 0:
            x = even_layer(x, c, *even_params[layer // 2])
        else:
            x = odd_layer(x, c, *odd_params[layer // 2])
    return x
```

```cpp
#include <hip/hip_runtime.h>
#include <hip/hip_cooperative_groups.h>
#include <cstdio>
#include <cstdint>
namespace cg = cooperative_groups;

#ifndef PH_MASK
#define PH_MASK 0xffff
#endif
#define EN(k) (((PH_MASK) >> (k)) & 1)
#ifndef MK_ONE_LAUNCH
#define MK_ONE_LAUNCH 1
#endif

#define LAS __attribute__((address_space(3)))
typedef unsigned short bf16_t;
typedef short bf16x8 __attribute__((ext_vector_type(8)));
typedef short s16x4 __attribute__((ext_vector_type(4)));
typedef float f32x4 __attribute__((ext_vector_type(4)));
typedef float f32x16 __attribute__((ext_vector_type(16)));
typedef unsigned u32x4 __attribute__((ext_vector_type(4)));
typedef unsigned u32x2 __attribute__((ext_vector_type(2)));

constexpr int BATCH = 8, SEQ = 4096, D = 1024, M = BATCH * SEQ, NIN = 2560, FF = 2816, NGU = 2 * FF, NQK = 2048, NMOD = 6 * D;
constexpr int NHEAD = 16, HD = 64;
constexpr float EPS = 1e-6f;
constexpr size_t MiB = 1u << 20;
constexpr size_t WS_MOD = 0, WS_BAR = 768 * 1024, WS_AGG = 1 * MiB, WS_WIN = 2 * MiB, WS_WO0 = 7 * MiB, WS_WGU0 = 9 * MiB, WS_WD0 = 20 * MiB, WS_WQK = 26 * MiB, WS_WV = 30 * MiB,
                 WS_WO1 = 32 * MiB, WS_WGU1 = 34 * MiB, WS_WD1 = 45 * MiB, WS_H = 52 * MiB, WS_Y = 116 * MiB, WS_BIG = 180 * MiB, WS_XR = 372 * MiB, WS_END = 436 * MiB;
constexpr size_t WS_ROWSS = 50 * MiB + 512 * 1024, WS_GSV = WS_ROWSS + 384 * 1024, WS_CVEC = 51 * MiB + 256 * 1024;
constexpr int CV_GU0 = 0, CV_QK = 8 * NGU, CV_V = CV_QK + 8 * NQK, CV_GU1 = CV_V + 8 * D;
constexpr size_t WS_Q = WS_BIG, WS_K = WS_BIG + 64 * MiB, WS_VT = WS_BIG + 128 * MiB;
constexpr int LDS_BYTES = 158 * 1024;
constexpr int MISC_OFF = LDS_BYTES - 64;
constexpr int NPHASE = 16;

typedef float f32x2_t __attribute__((ext_vector_type(2)));
typedef __bf16 bf16x2_t __attribute__((ext_vector_type(2)));
__device__ __forceinline__ unsigned cvt_pk_bf16(float lo, float hi) { const f32x2_t v = {lo, hi}; const bf16x2_t b = __builtin_convertvector(v, bf16x2_t); return __builtin_bit_cast(unsigned, b); }
__device__ __forceinline__ float bf2f(unsigned short h) { return __builtin_bit_cast(float, (unsigned)h << 16); }
__device__ __forceinline__ float bflo(unsigned u) { return __builtin_bit_cast(float, u << 16); }
__device__ __forceinline__ float bfhi(unsigned u) { return __builtin_bit_cast(float, u & 0xffff0000u); }
__device__ __forceinline__ float wave_sum(float v) {
#pragma unroll
    for (int o = 1; o < 64; o <<= 1) v += __shfl_xor(v, o);
    return v;
}

namespace pg8 {
#define PG8_LAS __attribute__((address_space(3)))
constexpr int BM = 256, BK = 64, HALF = 128, HTB = HALF * BK * 2, STAGE_BYTES = 8 * HTB, NXCD = 8, WGM = 8;
__host__ __device__ __forceinline__ int lds_byte(int r, int c) { const int st = (r >> 4) * 2 + (c >> 5), rr = r & 15, cc = c & 31, ob = rr * 64 + cc * 2; return st * 1024 + (ob ^ (((ob >> 9) & 1) << 5)); }
__host__ __device__ __forceinline__ void stage_rc(int b, int& R, int& C) { const int st = b / 1024, sb = b % 1024, swz = sb ^ (((sb >> 9) & 1) << 5); R = (st >> 1) * 16 + swz / 64; C = (st & 1) * 32 + (swz % 64) / 2; }
__host__ __device__ __forceinline__ int perm32(int rho) { const int n = rho >> 4, i = rho & 15; return 8 * (i >> 2) + 4 * n + (i & 3); }
struct Unit { int pm, pn; };
struct Gemm { const bf16_t* A; const bf16_t* Bt; int M, N, K; };
struct StaticOrder {
    int nM, nN, nwg, G, c;
    __host__ __device__ void init(int M, int N, int G_, int c_) { nM = M / BM; nN = N / BM; nwg = nM * nN; G = G_; c = c_; }
    __host__ __device__ bool next(int i, Unit& u) const {
        const long L = (long)i * G + c; if (L >= nwg) return false;
        int wgid = (int)L; { const int q = nwg / NXCD, r = nwg % NXCD, xcd = wgid % NXCD, off = wgid / NXCD; wgid = (xcd < r ? xcd * (q + 1) : r * (q + 1) + (xcd - r) * q) + off; }
        const int nig = WGM * nN, gid = wgid / nig, fm = gid * WGM, gsz = (nM - fm) < WGM ? (nM - fm) : WGM;
        u.pm = fm + ((wgid % nig) % gsz); u.pn = (wgid % nig) / gsz; return true;
    }
    __device__ __forceinline__ void a_ready(const Unit&) const {}
    __device__ __forceinline__ void done(const Unit&) const {}
};

template <class Epi, class Sched, bool ALIGN_EPI = false, bool SP2 = false>
__device__ __forceinline__ void gemm_phase(PG8_LAS unsigned char* lds, const Gemm g, const Sched& S, const Epi& E) {
    const int tid = threadIdx.x, wid = __builtin_amdgcn_readfirstlane(tid >> 6), lane = tid & 63, wr = wid >> 2, wc = wid & 3, fr = lane & 15, fq = lane >> 4;
    const int K = g.K, nt = K / BK;
    unsigned voffA[2], voffB[2];
#pragma unroll
    for (int i = 0; i < 2; ++i) { int R, C; stage_rc(tid * 16 + i * 8192, R, C); const int Rb = Epi::PERM ? ((R & ~31) + perm32(R & 31)) : R;
        voffA[i] = (unsigned)(R * K + C) * 2u; voffB[i] = (unsigned)(Rb * K + C) * 2u; }
    const size_t kstep = (size_t)(BK * 2);
    const size_t hstep = (size_t)HALF * K * 2;
    const size_t tstep = 2 * hstep;
    const unsigned ldsw = (unsigned)wid * 1024u;
    const int aoff = lds_byte(wr * 64 + fr, fq * 8), boff = lds_byte(wc * 32 + fr, fq * 8);
#define PG8_SA(b, h) (((b) * 2 + (h)) * HTB)
#define PG8_SB(b, h) ((4 + (b) * 2 + (h)) * HTB)
#define PG8_STAGE(bufoff, gbase, voff) do { _Pragma("unroll") for (int _i = 0; _i < 2; ++_i) \
        __builtin_amdgcn_global_load_lds((const unsigned*)((const char*)(gbase) + (voff)[_i]), (PG8_LAS unsigned*)(lds + (bufoff) + ldsw + _i * 8192), 16, 0, 0); } while (0)
#define PG8_LDA(dst, b, h) do { _Pragma("unroll") for (int m = 0; m < 4; ++m) _Pragma("unroll") for (int k = 0; k < 2; ++k) dst[m][k] = *(const PG8_LAS bf16x8*)(lds + PG8_SA(b, h) + aoff + m * 2048 + k * 1024); } while (0)
#define PG8_LDB(dst, b, h) do { _Pragma("unroll") for (int n = 0; n < 2; ++n) _Pragma("unroll") for (int k = 0; k < 2; ++k) dst[n][k] = *(const PG8_LAS bf16x8*)(lds + PG8_SB(b, h) + boff + n * 2048 + k * 1024); } while (0)
#define PG8_MMA(ai, bj, At, Bt) do { __builtin_amdgcn_s_setprio(1); _Pragma("unroll") for (int m = 0; m < 4; ++m) _Pragma("unroll") for (int n = 0; n < 2; ++n) _Pragma("unroll") for (int k = 0; k < 2; ++k) \
        acc[ai][bj][m][n] = __builtin_amdgcn_mfma_f32_16x16x32_bf16(Bt[n][k], At[m][k], acc[ai][bj][m][n], 0, 0, 0); __builtin_amdgcn_s_setprio(0); } while (0)
#define PG8_WAIT_V(n) asm volatile("s_waitcnt vmcnt(" #n ")" ::: "memory")
#define PG8_WAIT_L(n) asm volatile("s_waitcnt lgkmcnt(" #n ")" ::: "memory")
#define PG8_BAR __builtin_amdgcn_s_barrier()
#define PG8_SCHED __builtin_amdgcn_sched_barrier(0)
    Unit cur, nxt; int ui = 0;
    if (!S.next(0, cur)) return;
    f32x4 acc[2][2][4][2];
#pragma unroll
    for (int a = 0; a < 2; ++a)
#pragma unroll
        for (int b = 0; b < 2; ++b)
#pragma unroll
            for (int m = 0; m < 4; ++m)
#pragma unroll
                for (int n = 0; n < 2; ++n) acc[a][b][m][n] = (f32x4){0.f, 0.f, 0.f, 0.f};
    bf16x8 At[4][2], B0[2][2], B1[2][2];
    const char* cA = (const char*)g.A + (size_t)cur.pm * tstep; const char* cB = (const char*)g.Bt + (size_t)cur.pn * tstep;
    S.a_ready(cur);
    if constexpr (SP2) {
        PG8_STAGE(PG8_SB(0, 0), cB, voffB); PG8_STAGE(PG8_SB(0, 1), cB + hstep, voffB); PG8_STAGE(PG8_SA(0, 0), cA, voffA); PG8_STAGE(PG8_SA(0, 1), cA + hstep, voffA);
        if (wr == 1) PG8_BAR;
        PG8_WAIT_V(2); PG8_BAR;
        PG8_STAGE(PG8_SB(1, 0), cB + kstep, voffB); PG8_STAGE(PG8_SA(1, 0), cA + kstep, voffA); PG8_STAGE(PG8_SB(1, 1), cB + hstep + kstep, voffB);
        PG8_WAIT_V(6); PG8_BAR;
    } else {
        PG8_STAGE(PG8_SB(0, 0), cB, voffB); PG8_STAGE(PG8_SA(0, 0), cA, voffA); PG8_STAGE(PG8_SB(0, 1), cB + hstep, voffB); PG8_STAGE(PG8_SA(0, 1), cA + hstep, voffA);
        if (wr == 1) PG8_BAR;
        PG8_WAIT_V(4); PG8_BAR;
        PG8_STAGE(PG8_SB(1, 0), cB + kstep, voffB); PG8_STAGE(PG8_SA(1, 0), cA + kstep, voffA); PG8_STAGE(PG8_SB(1, 1), cB + hstep + kstep, voffB);
        PG8_WAIT_V(6); PG8_BAR;
    }
    for (;;) {
        const bool has_next = S.next(ui + 1, nxt);
        const char* nA = has_next ? (const char*)g.A + (size_t)nxt.pm * tstep : cA; const char* nB = has_next ? (const char*)g.Bt + (size_t)nxt.pn * tstep : cB;
        for (int t = 0; t < nt; t += 2) {
            const bool last = (t == nt - 2);
            const char* a1 = cA + (size_t)(t + 1) * kstep;
            const char* a2 = last ? nA : cA + (size_t)(t + 2) * kstep; const char* b2 = last ? nB : cB + (size_t)(t + 2) * kstep;
            const char* a3 = a2 + kstep; const char* b3 = b2 + kstep;
            if (last && has_next) S.a_ready(nxt);
            if constexpr (SP2) {
            PG8_LDB(B0, 0, 0); PG8_LDB(B1, 0, 1); PG8_SCHED; PG8_LDA(At, 0, 0); PG8_STAGE(PG8_SA(1, 1), a1 + hstep, voffA);
            PG8_WAIT_V(8); PG8_WAIT_L(0); PG8_BAR; PG8_MMA(0, 0, At, B0); PG8_MMA(0, 1, At, B1); PG8_BAR; PG8_SCHED;
            PG8_LDA(At, 0, 1); PG8_STAGE(PG8_SB(0, 0), b2, voffB); PG8_STAGE(PG8_SB(0, 1), b2 + hstep, voffB); PG8_STAGE(PG8_SA(0, 0), a2, voffA);
            PG8_WAIT_V(8); PG8_WAIT_L(0); PG8_BAR; PG8_MMA(1, 0, At, B0); PG8_MMA(1, 1, At, B1); PG8_BAR; PG8_SCHED;
            PG8_LDB(B0, 1, 0); PG8_LDB(B1, 1, 1); PG8_SCHED; PG8_LDA(At, 1, 0); PG8_STAGE(PG8_SA(0, 1), a2 + hstep, voffA);
            PG8_WAIT_V(8); PG8_WAIT_L(0); PG8_BAR; PG8_MMA(0, 0, At, B0); PG8_MMA(0, 1, At, B1); PG8_BAR; PG8_SCHED;
            PG8_LDA(At, 1, 1); PG8_STAGE(PG8_SB(1, 0), b3, voffB); PG8_STAGE(PG8_SB(1, 1), b3 + hstep, voffB); PG8_STAGE(PG8_SA(1, 0), a3, voffA);
            PG8_WAIT_V(8); PG8_WAIT_L(0); PG8_BAR; PG8_MMA(1, 0, At, B0); PG8_MMA(1, 1, At, B1); PG8_BAR; PG8_SCHED;
            } else {
            PG8_LDB(B0, 0, 0); PG8_SCHED; PG8_LDA(At, 0, 0); PG8_STAGE(PG8_SA(1, 1), a1 + hstep, voffA);
            PG8_WAIT_L(8); PG8_BAR; PG8_WAIT_L(0); PG8_MMA(0, 0, At, B0); PG8_BAR; PG8_SCHED;
            PG8_LDB(B1, 0, 1); PG8_STAGE(PG8_SB(0, 0), b2, voffB);
            PG8_BAR; PG8_WAIT_L(0); PG8_MMA(0, 1, At, B1); PG8_BAR;
            PG8_LDA(At, 0, 1); PG8_STAGE(PG8_SA(0, 0), a2, voffA);
            PG8_BAR; PG8_WAIT_L(0); PG8_MMA(1, 0, At, B0); PG8_BAR; PG8_SCHED;
            PG8_STAGE(PG8_SB(0, 1), b2 + hstep, voffB);
            PG8_WAIT_V(6); PG8_BAR; PG8_MMA(1, 1, At, B1); PG8_BAR;
            PG8_LDB(B0, 1, 0); PG8_SCHED; PG8_LDA(At, 1, 0); PG8_STAGE(PG8_SA(0, 1), a2 + hstep, voffA);
            PG8_WAIT_L(8); PG8_BAR; PG8_WAIT_L(0); PG8_MMA(0, 0, At, B0); PG8_BAR; PG8_SCHED;
            PG8_LDB(B1, 1, 1); PG8_STAGE(PG8_SB(1, 0), b3, voffB);
            PG8_BAR; PG8_WAIT_L(0); PG8_MMA(0, 1, At, B1); PG8_BAR;
            PG8_LDA(At, 1, 1); PG8_STAGE(PG8_SA(1, 0), a3, voffA);
            PG8_BAR; PG8_WAIT_L(0); PG8_MMA(1, 0, At, B0); PG8_BAR; PG8_SCHED;
            PG8_STAGE(PG8_SB(1, 1), b3 + hstep, voffB);
            PG8_WAIT_V(6); PG8_BAR; PG8_MMA(1, 1, At, B1); PG8_BAR;
            }
        }
        if constexpr (ALIGN_EPI) { if (wr == 0) PG8_BAR; }
        E(acc, cur, wr, wc, fr, fq); S.done(cur);
        if (!has_next) break;
#pragma unroll
        for (int a = 0; a < 2; ++a)
#pragma unroll
            for (int b = 0; b < 2; ++b)
#pragma unroll
                for (int m = 0; m < 4; ++m)
#pragma unroll
                    for (int n = 0; n < 2; ++n) acc[a][b][m][n] = (f32x4){0.f, 0.f, 0.f, 0.f};
        cur = nxt; cA = nA; cB = nB; ++ui;
        if constexpr (ALIGN_EPI) { if (wr == 1) PG8_BAR; }
    }
    PG8_WAIT_V(0);
    if constexpr (!ALIGN_EPI) { if (wr == 0) PG8_BAR; }
    PG8_BAR;
#undef PG8_SA
#undef PG8_SB
#undef PG8_STAGE
#undef PG8_LDA
#undef PG8_LDB
#undef PG8_MMA
#undef PG8_WAIT_V
#undef PG8_WAIT_L
#undef PG8_BAR
#undef PG8_SCHED
}

struct EpiBf16 {
    static constexpr bool PERM = true;
    bf16_t* O; int ldc;
    __device__ __forceinline__ void operator()(const f32x4 (&acc)[2][2][4][2], const Unit& u, int wr, int wc, int fr, int fq) const {
        const int row0 = u.pm * BM + wr * 64 + fr, col0 = u.pn * BM + wc * 32 + 8 * fq;
#pragma unroll
        for (int ai = 0; ai < 2; ++ai)
#pragma unroll
            for (int m = 0; m < 4; ++m) { bf16_t* rowp = O + (size_t)(row0 + ai * HALF + m * 16) * ldc + col0;
#pragma unroll
                for (int bj = 0; bj < 2; ++bj) { const f32x4 v0 = acc[ai][bj][m][0], v1 = acc[ai][bj][m][1];
                    u32x4 w; w.x = cvt_pk_bf16(v0[0], v0[1]); w.y = cvt_pk_bf16(v0[2], v0[3]); w.z = cvt_pk_bf16(v1[0], v1[1]); w.w = cvt_pk_bf16(v1[2], v1[3]);
                    *(u32x4*)(rowp + bj * HALF) = w; } }
    }
};
struct EpiVt {
    static constexpr bool PERM = true;
    bf16_t* O; const float* rowss; const float* cvec;
    __device__ __forceinline__ void operator()(const f32x4 (&acc)[2][2][4][2], const Unit& u, int wr, int wc, int fr, int fq) const {
        const int row0 = u.pm * BM + wr * 64 + fr, col0 = u.pn * BM + wc * 32 + 8 * fq;
        f32x4 rs[2][2];
#pragma unroll
        for (int bj = 0; bj < 2; ++bj)
#pragma unroll
            for (int n = 0; n < 2; ++n) { const f32x4 q = *(const f32x4*)(rowss + col0 + bj * HALF + 4 * n);
#pragma unroll
                for (int e = 0; e < 4; ++e) rs[bj][n][e] = __builtin_amdgcn_rsqf(q[e] * (1.0f / D) + EPS); }
        const float* cb = cvec + (size_t)(u.pn >> 4) * D;
        float crv[2][4];
#pragma unroll
        for (int ai = 0; ai < 2; ++ai)
#pragma unroll
            for (int m = 0; m < 4; ++m) crv[ai][m] = cb[row0 + ai * HALF + m * 16];
#pragma unroll
        for (int ai = 0; ai < 2; ++ai)
#pragma unroll
            for (int m = 0; m < 4; ++m) { const int r = row0 + ai * HALF + m * 16; const int hh = r >> 6, d = r & 63; const float cr = crv[ai][m];
#pragma unroll
                for (int bj = 0; bj < 2; ++bj) { const int col = col0 + bj * HALF; const int b = col >> 12, sq = col & 4095;
                    bf16_t* p = O + ((size_t)((b * NHEAD + hh) * 128 + (sq >> 5)) * 4 + (d >> 5) * 2 + ((sq >> 4) & 1)) * 512 + (((sq >> 3) & 1) * 32 + (d & 31)) * 8;
                    const f32x4 v0 = acc[ai][bj][m][0] * rs[bj][0] + cr, v1 = acc[ai][bj][m][1] * rs[bj][1] + cr;
                    u32x4 w; w.x = cvt_pk_bf16(v0[0], v0[1]); w.y = cvt_pk_bf16(v0[2], v0[3]); w.z = cvt_pk_bf16(v1[0], v1[1]); w.w = cvt_pk_bf16(v1[2], v1[3]);
                    *(u32x4*)p = w; } }
    }
};
template <bool FUSE, bool RES_BF16, bool OUT_F32> struct EpiRes {
    static constexpr bool PERM = true;
    const void* res; float* out; const float* gate_l;
    bf16_t* Hn; const float* gs_l; float* rowss;
    const float* rgs_l;
    __device__ __forceinline__ void operator()(const f32x4 (&acc)[2][2][4][2], const Unit& u, int wr, int wc, int fr, int fq) const {
        const int row0 = u.pm * BM + wr * 64 + fr, col0 = u.pn * BM + wc * 32 + 8 * fq;
        const float* gate = gate_l + (size_t)(u.pm >> 4) * NMOD + col0;
        f32x4 gv[2][2], gs[2][2], rg[2][2];
#pragma unroll
        for (int bj = 0; bj < 2; ++bj)
#pragma unroll
            for (int n = 0; n < 2; ++n) { gv[bj][n] = *(const f32x4*)(gate + bj * HALF + 4 * n);
                if constexpr (FUSE) gs[bj][n] = *(const f32x4*)(gs_l + (size_t)(u.pm >> 4) * D + col0 + bj * HALF + 4 * n);
                if constexpr (RES_BF16) rg[bj][n] = *(const f32x4*)(rgs_l + (size_t)(u.pm >> 4) * D + col0 + bj * HALF + 4 * n); }
#pragma unroll
        for (int ai = 0; ai < 2; ++ai) {
          constexpr int MH = 2;
#pragma unroll
          for (int m0 = 0; m0 < 4; m0 += MH) {
            f32x4 rr[MH][2][2]; u32x4 rb[MH][2];
#pragma unroll
            for (int mm = 0; mm < MH; ++mm) { const size_t off = (size_t)(row0 + ai * HALF + (m0 + mm) * 16) * D + col0;
#pragma unroll
                for (int bj = 0; bj < 2; ++bj) {
                    if constexpr (RES_BF16) rb[mm][bj] = *(const u32x4*)((const bf16_t*)res + off + bj * HALF);
                    else { rr[mm][bj][0] = *(const f32x4*)((const float*)res + off + bj * HALF); rr[mm][bj][1] = *(const f32x4*)((const float*)res + off + bj * HALF + 4); } } }
#pragma unroll
            for (int mm = 0; mm < MH; ++mm) { const int m = m0 + mm; const int row = row0 + ai * HALF + m * 16; const size_t off = (size_t)row * D + col0;
                float ss = 0.f;
#pragma unroll
                for (int bj = 0; bj < 2; ++bj) {
                    f32x4 r[2], o[2];
                    if constexpr (RES_BF16) { const u32x4 q = rb[mm][bj];
                        r[0] = (f32x4){bflo(q.x), bfhi(q.x), bflo(q.y), bfhi(q.y)} * rg[bj][0]; r[1] = (f32x4){bflo(q.z), bfhi(q.z), bflo(q.w), bfhi(q.w)} * rg[bj][1]; }
                    else { r[0] = rr[mm][bj][0]; r[1] = rr[mm][bj][1]; }
#pragma unroll
                    for (int n = 0; n < 2; ++n) o[n] = r[n] + gv[bj][n] * acc[ai][bj][m][n];
                    if constexpr (OUT_F32) { __builtin_nontemporal_store(o[0], (f32x4*)(out + off + bj * HALF)); __builtin_nontemporal_store(o[1], (f32x4*)(out + off + bj * HALF + 4)); }
                    if constexpr (FUSE) {
                        ss += (o[0][0] * o[0][0] + o[0][1] * o[0][1]) + (o[0][2] * o[0][2] + o[0][3] * o[0][3]) + (o[1][0] * o[1][0] + o[1][1] * o[1][1]) + (o[1][2] * o[1][2] + o[1][3] * o[1][3]);
                        const f32x4 y0 = o[0] * gs[bj][0], y1 = o[1] * gs[bj][1];
                        u32x4 w; w.x = cvt_pk_bf16(y0[0], y0[1]); w.y = cvt_pk_bf16(y0[2], y0[3]); w.z = cvt_pk_bf16(y1[0], y1[1]); w.w = cvt_pk_bf16(y1[2], y1[3]);
                        *(u32x4*)(Hn + off + bj * HALF) = w; } }
                if constexpr (FUSE) { ss += __shfl_xor(ss, 16); ss += __shfl_xor(ss, 32); if (fq == 0) atomicAdd(rowss + row, ss); } }
          }
        }
    }
};
__device__ __forceinline__ float silu_f(float g) { return g * __builtin_amdgcn_rcpf(1.0f + __expf(-g)); }
struct EpiSwiGLU {
    static constexpr bool PERM = true;
    bf16_t* O; const float* rowss; const float* cvec;
    __device__ __forceinline__ void operator()(const f32x4 (&acc)[2][2][4][2], const Unit& u, int wr, int wc, int fr, int fq) const {
        const int row0 = u.pm * BM + wr * 64 + fr, col0 = u.pn * HALF + wc * 32 + 8 * fq;
        const float* cp = cvec + (size_t)(u.pm >> 4) * NGU + u.pn * BM + wc * 32 + 8 * fq;
        const f32x4 cg0 = *(const f32x4*)cp, cg1 = *(const f32x4*)(cp + 4), cu0 = *(const f32x4*)(cp + HALF), cu1 = *(const f32x4*)(cp + HALF + 4);
        float rsv[2][4];
#pragma unroll
        for (int ai = 0; ai < 2; ++ai)
#pragma unroll
            for (int m = 0; m < 4; ++m) rsv[ai][m] = rowss[row0 + ai * HALF + m * 16];
#pragma unroll
        for (int ai = 0; ai < 2; ++ai)
#pragma unroll
            for (int m = 0; m < 4; ++m) { const int row = row0 + ai * HALF + m * 16; bf16_t* rowp = O + (size_t)row * FF + col0;
                const float rstd = __builtin_amdgcn_rsqf(rsv[ai][m] * (1.0f / D) + EPS);
                const f32x4 g0 = acc[ai][0][m][0] * rstd + cg0, g1 = acc[ai][0][m][1] * rstd + cg1, u0 = acc[ai][1][m][0] * rstd + cu0, u1 = acc[ai][1][m][1] * rstd + cu1;
                u32x4 w; w.x = cvt_pk_bf16(silu_f(g0[0]) * u0[0], silu_f(g0[1]) * u0[1]); w.y = cvt_pk_bf16(silu_f(g0[2]) * u0[2], silu_f(g0[3]) * u0[3]);
                w.z = cvt_pk_bf16(silu_f(g1[0]) * u1[0], silu_f(g1[1]) * u1[1]); w.w = cvt_pk_bf16(silu_f(g1[2]) * u1[2], silu_f(g1[3]) * u1[3]);
                *(u32x4*)rowp = w; }
    }
};
struct EpiQK {
    static constexpr bool PERM = true;
    bf16_t* Qb; bf16_t* Kb; const float* qg; const float* kg; const float* rowss; const float* cvec;
    __device__ __forceinline__ void operator()(const f32x4 (&acc)[2][2][4][2], const Unit& u, int wr, int wc, int fr, int fq) const {
        const bool isq = u.pn < 4; const int hh = (u.pn & 3) * 4 + wc;
        const float* gp = (isq ? qg : kg) + 8 * fq; bf16_t* base = isq ? Qb : Kb;
        const float sc = isq ? 0.125f * 1.4426950408889634f : 1.0f;
        f32x4 gv[2][2];
#pragma unroll
        for (int bj = 0; bj < 2; ++bj)
#pragma unroll
            for (int n = 0; n < 2; ++n) gv[bj][n] = *(const f32x4*)(gp + 32 * bj + 4 * n) * sc;
        const int row0 = u.pm * BM + wr * 64 + fr;
        f32x4 cv[2][2];
        { const float* cp = cvec + (size_t)(u.pm >> 4) * NQK + u.pn * BM + wc * 32 + 8 * fq;
#pragma unroll
          for (int bj = 0; bj < 2; ++bj)
#pragma unroll
              for (int n = 0; n < 2; ++n) cv[bj][n] = *(const f32x4*)(cp + bj * HALF + 4 * n); }
        float rsv[2][4];
#pragma unroll
        for (int ai = 0; ai < 2; ++ai)
#pragma unroll
            for (int m = 0; m < 4; ++m) rsv[ai][m] = rowss[row0 + ai * HALF + m * 16];
#pragma unroll
        for (int ai = 0; ai < 2; ++ai)
#pragma unroll
            for (int m = 0; m < 4; ++m) { const int row = row0 + ai * HALF + m * 16; const int b = row >> 12, s = row & 4095;
                const float rs0 = __builtin_amdgcn_rsqf(rsv[ai][m] * (1.0f / D) + EPS);
                f32x4 xv[2][2];
                float ss = 0.f;
#pragma unroll
                for (int bj = 0; bj < 2; ++bj)
#pragma unroll
                    for (int n = 0; n < 2; ++n) { const f32x4 x = acc[ai][bj][m][n] * rs0 + cv[bj][n]; xv[bj][n] = x; ss += (x[0] * x[0] + x[1] * x[1]) + (x[2] * x[2] + x[3] * x[3]); }
                ss += __shfl_xor(ss, 16); ss += __shfl_xor(ss, 32);
                const float rstd = __builtin_amdgcn_rsqf(ss * (1.0f / 64.0f) + EPS);
                const int lr = s & 31; const int lrow = isq ? lr : ((lr & 19) | ((lr & 4) << 1) | ((lr & 8) >> 1));
                bf16_t* rowp = base + ((size_t)((b * NHEAD + hh) * 128 + (s >> 5)) * 4 + (fq >> 1)) * 512 + ((fq & 1) * 32 + lrow) * 8;
#pragma unroll
                for (int bj = 0; bj < 2; ++bj) { const f32x4 v0 = xv[bj][0] * gv[bj][0] * rstd, v1 = xv[bj][1] * gv[bj][1] * rstd;
                    u32x4 w; w.x = cvt_pk_bf16(v0[0], v0[1]); w.y = cvt_pk_bf16(v0[2], v0[3]); w.z = cvt_pk_bf16(v1[0], v1[1]); w.w = cvt_pk_bf16(v1[2], v1[3]);
                    *(u32x4*)(rowp + (2 * bj) * 512) = w; } }
    }
};
}

struct Args { const float* in[30]; float* out; unsigned char* ws; int ph_lo, ph_hi, coop, pad; };

__device__ __forceinline__ void transpose_item(const float* W, int K, int N, bf16_t* WT, int k0, int n0, int rbase, float* scr, int lane) {
    float tv[32];
#pragma unroll
    for (int i = 0; i < 32; ++i) tv[i] = __builtin_nontemporal_load(W + (size_t)(k0 + 2 * i + (lane >> 5)) * N + n0 + (lane & 31));
#pragma unroll
    for (int i = 0; i < 32; ++i) scr[(2 * i + (lane >> 5)) * 33 + (lane & 31)] = tv[i];
    __builtin_amdgcn_s_waitcnt(0xc07f); asm volatile("" ::: "memory");
    const int c = lane & 7;
#pragma unroll
    for (int j = 0; j < 4; ++j) { const int n = (lane >> 3) + 8 * j; const float* s = scr + (8 * c) * 33 + n;
        u32x4 o; o.x = cvt_pk_bf16(s[0 * 33], s[1 * 33]); o.y = cvt_pk_bf16(s[2 * 33], s[3 * 33]); o.z = cvt_pk_bf16(s[4 * 33], s[5 * 33]); o.w = cvt_pk_bf16(s[6 * 33], s[7 * 33]);
        *(u32x4*)(WT + (size_t)(rbase + n) * K + k0 + 8 * c) = o; }
    __builtin_amdgcn_s_waitcnt(0xc07f); asm volatile("" ::: "memory");
}
__device__ __forceinline__ void p0_prologue(const Args& a, unsigned char* lds) {
    const int tid = threadIdx.x, lane = tid & 63, w = tid >> 6;
    float* mod = (float*)(a.ws + WS_MOD);
    float* sc = (float*)lds; float* part = (float*)(lds + 32768);
    if ((int)blockIdx.x < 192) {
        const float* c = a.in[1];
        for (int e = tid; e < BATCH * D; e += 512) { const float v = c[e]; sc[e] = v / (1.0f + expf(-v)); }
        __syncthreads();
        for (int unit = blockIdx.x; unit < 192; unit += gridDim.x) {
            const int l = unit / 96, j = (unit % 96) * 64 + lane;
            const float* W = l == 0 ? a.in[2] : a.in[19]; const float* bias = l == 0 ? a.in[3] : a.in[20];
            float acc[8];
#pragma unroll
            for (int b = 0; b < 8; ++b) acc[b] = 0.f;
#pragma unroll 16
            for (int kk = 0; kk < 128; ++kk) { const int k = w * 128 + kk; const float wv = __builtin_nontemporal_load(W + (size_t)k * NMOD + j);
#pragma unroll
                for (int b = 0; b < 8; ++b) acc[b] += sc[b * D + k] * wv; }
#pragma unroll
            for (int b = 0; b < 8; ++b) part[(w * 8 + b) * 64 + lane] = acc[b];
            __syncthreads();
            { float s = 0.f;
#pragma unroll
              for (int ww = 0; ww < 8; ++ww) s += part[(ww * 8 + w) * 64 + lane];
              mod[(size_t)(l * 8 + w) * NMOD + j] = s + bias[j]; }
            __syncthreads();
        }
    }
    __syncthreads();
    float* scr = (float*)(lds + w * 16384);
    const int gw = blockIdx.x * 8 + w, NGW = gridDim.x * 8;
    constexpr int I_IN = 16 * (NIN / 32), I_O = 16 * 32, I_G = 16 * (FF / 32), I_D = (FF / 64) * 32, I_QKV = 16 * 96;
    constexpr int NITEMS = I_IN + 2 * I_O + 4 * I_G + 2 * I_D + I_QKV;
    static_assert(NITEMS == 12288, "item split below assumes 12288 items");
    const bool bal = (gridDim.x == 256);
    const int nmine = !bal ? 0 : ((int)blockIdx.x < 192 ? 5 : 9);
    const int first = !bal ? gw : ((int)blockIdx.x < 192 ? gw : 7680 + (gw - 1536)), stride = !bal ? NGW : ((int)blockIdx.x < 192 ? 1536 : 512);
    for (int it = first, cntI = 0; bal ? (cntI < nmine) : (it < NITEMS); it += stride, ++cntI) {
        int r = it;
        if (r < I_IN) { const int nb = NIN / 32; transpose_item(a.in[5], D, NIN, (bf16_t*)(a.ws + WS_WIN), 64 * (r / nb), 32 * (r % nb), 32 * (r % nb), scr, lane); continue; } r -= I_IN;
        if (r < I_O) { transpose_item(a.in[14], D, D, (bf16_t*)(a.ws + WS_WO0), 64 * (r / 32), 32 * (r % 32), 32 * (r % 32), scr, lane); continue; } r -= I_O;
        if (r < I_O) { transpose_item(a.in[25], D, D, (bf16_t*)(a.ws + WS_WO1), 64 * (r / 32), 32 * (r % 32), 32 * (r % 32), scr, lane); continue; } r -= I_O;
        if (r < 4 * I_G) { const int which = r / I_G; r -= which * I_G;
            const int nb = FF / 32, n0 = 32 * (r % nb); const int rb = (n0 >> 7) * 256 + (n0 & 127) + ((which & 1) ? 128 : 0);
            const float* src = which == 0 ? a.in[16] : which == 1 ? a.in[17] : which == 2 ? a.in[27] : a.in[28];
            transpose_item(src, D, FF, (bf16_t*)(a.ws + (which < 2 ? WS_WGU0 : WS_WGU1)), 64 * (r / nb), n0, rb, scr, lane); continue; } r -= 4 * I_G;
        if (r < 2 * I_D) { const int which = r / I_D; r -= which * I_D;
            transpose_item(which == 0 ? a.in[18] : a.in[29], FF, D, (bf16_t*)(a.ws + (which == 0 ? WS_WD0 : WS_WD1)), 64 * (r / 32), 32 * (r % 32), 32 * (r % 32), scr, lane); continue; } r -= 2 * I_D;
        { const int n0 = 32 * (r % 96), k0 = 64 * (r / 96);
          if (n0 < NQK) { const int which = n0 >> 10, hh = (n0 & 1023) >> 6, dh = (n0 & 63) >> 5; const int rb = (which * 4 + (hh >> 2)) * 256 + 128 * dh + 32 * (hh & 3);
              transpose_item(a.in[22], D, 3 * D, (bf16_t*)(a.ws + WS_WQK), k0, n0, rb, scr, lane); }
          else transpose_item(a.in[22], D, 3 * D, (bf16_t*)(a.ws + WS_WV), k0, n0, n0 - NQK, scr, lane); }
    }
}

__device__ __forceinline__ void norm_phase(const float* src, const float* gain, const float* shift_l, const float* scale_l, bf16_t* H) {
    const int lane = threadIdx.x & 63, w = threadIdx.x >> 6;
    const int gw = blockIdx.x * 8 + w, NGW = gridDim.x * 8;
    f32x4 g[4];
#pragma unroll
    for (int j = 0; j < 4; ++j) g[j] = *((const f32x4*)gain + lane + 64 * j);
    for (int m0 = gw * 4; m0 < M; m0 += NGW * 4) {
        f32x4 v[4][4]; float s[4];
#pragma unroll
        for (int r = 0; r < 4; ++r) { const f32x4* xr = (const f32x4*)(src + (size_t)(m0 + r) * D) + lane;
#pragma unroll
            for (int j = 0; j < 4; ++j) v[r][j] = __builtin_nontemporal_load(xr + 64 * j); }
#pragma unroll
        for (int r = 0; r < 4; ++r) { s[r] = 0.f;
#pragma unroll
            for (int j = 0; j < 4; ++j) s[r] += (v[r][j].x * v[r][j].x + v[r][j].y * v[r][j].y) + (v[r][j].z * v[r][j].z + v[r][j].w * v[r][j].w); }
        const int b = m0 >> 12;
        const f32x4* shp = (const f32x4*)(shift_l + (size_t)b * NMOD) + lane; const f32x4* scp = (const f32x4*)(scale_l + (size_t)b * NMOD) + lane;
#pragma unroll
        for (int r = 0; r < 4; ++r) { const float rstd = 1.0f / sqrtf(wave_sum(s[r]) * (1.0f / D) + EPS);
            u32x2* o8 = (u32x2*)(H + (size_t)(m0 + r) * D) + lane;
#pragma unroll
            for (int j = 0; j < 4; ++j) { const f32x4 sh = shp[64 * j], sc = scp[64 * j]; const f32x4 y = v[r][j] * rstd * g[j] * (sc + 1.0f) + sh;
                u32x2 o; o.x = cvt_pk_bf16(y.x, y.y); o.y = cvt_pk_bf16(y.z, y.w); o8[64 * j] = o; } }
    }
}

__device__ __forceinline__ void p1_extras(const Args& a, unsigned char* lds) {
    const int tid = threadIdx.x, lane = tid & 63, w = tid >> 6;
    const float* mod = (const float*)(a.ws + WS_MOD);
    float* rowss = (float*)(a.ws + WS_ROWSS); float* gsv = (float*)(a.ws + WS_GSV); float* cvec = (float*)(a.ws + WS_CVEC);
    const int gt = blockIdx.x * 512 + tid, NT = gridDim.x * 512;
    for (int e = gt; e < 3 * M; e += NT) rowss[e] = 0.f;
    for (int e = gt; e < 3 * 8 * D; e += NT) { const int nrm = e >> 13, b = (e >> 10) & 7, col = e & 1023;
        const float g = (nrm == 0 ? a.in[15] : nrm == 1 ? a.in[21] : a.in[26])[col];
        const float sc = mod[(size_t)((nrm == 0 ? 0 : 8) + b) * NMOD + (nrm == 1 ? 1 : 4) * D + col];
        float gsc = g * (1.0f + sc); if (fabsf(gsc) < 1e-12f) gsc = gsc < 0.f ? -1e-12f : 1e-12f;
        gsv[e] = gsc; gsv[3 * 8 * D + e] = 1.0f / gsc; }
    float* shl = (float*)lds;
#pragma unroll
    for (int q = 0; q < 12; ++q) { const int e = (tid + 512 * q) * 4, st = e >> 13, b = (e >> 10) & 7, k = e & 1023;
        *(f32x4*)(shl + e) = *(const f32x4*)(mod + (size_t)((st == 0 ? 0 : 8) + b) * NMOD + (st == 1 ? 0 : 3) * D + k); }
    __syncthreads();
    const int gw = blockIdx.x * 8 + w, NGW = gridDim.x * 8;
    for (int r = gw; r < NGU + NQK + D + NGU; r += NGW) {
        const bf16_t* wrow; const float* sh; float* dst; int nstride;
        if (r < NGU) { wrow = (const bf16_t*)(a.ws + WS_WGU0) + (size_t)r * D; sh = shl; dst = cvec + CV_GU0 + r; nstride = NGU; }
        else if (r < NGU + NQK) { const int q = r - NGU; wrow = (const bf16_t*)(a.ws + WS_WQK) + (size_t)q * D; sh = shl + 8 * D; dst = cvec + CV_QK + q; nstride = NQK; }
        else if (r < NGU + NQK + D) { const int q = r - NGU - NQK; wrow = (const bf16_t*)(a.ws + WS_WV) + (size_t)q * D; sh = shl + 8 * D; dst = cvec + CV_V + q; nstride = D; }
        else { const int q = r - NGU - NQK - D; wrow = (const bf16_t*)(a.ws + WS_WGU1) + (size_t)q * D; sh = shl + 16 * D; dst = cvec + CV_GU1 + q; nstride = NGU; }
        const u32x4 wa = *(const u32x4*)(wrow + 8 * lane), wb = *(const u32x4*)(wrow + 512 + 8 * lane);
        float wf[16];
#pragma unroll
        for (int q = 0; q < 4; ++q) { wf[2 * q] = bflo(wa[q]); wf[2 * q + 1] = bfhi(wa[q]); wf[8 + 2 * q] = bflo(wb[q]); wf[8 + 2 * q + 1] = bfhi(wb[q]); }
        float myv = 0.f;
#pragma unroll
        for (int b = 0; b < 8; ++b) { const float* sp = sh + b * D + 8 * lane;
            const f32x4 s0 = *(const f32x4*)sp, s1 = *(const f32x4*)(sp + 4), s2 = *(const f32x4*)(sp + 512), s3 = *(const f32x4*)(sp + 516);
            float p = wf[0] * s0[0] + wf[1] * s0[1] + wf[2] * s0[2] + wf[3] * s0[3] + wf[4] * s1[0] + wf[5] * s1[1] + wf[6] * s1[2] + wf[7] * s1[3]
                    + wf[8] * s2[0] + wf[9] * s2[1] + wf[10] * s2[2] + wf[11] * s2[3] + wf[12] * s3[0] + wf[13] * s3[1] + wf[14] * s3[2] + wf[15] * s3[3];
            p = wave_sum(p); if (lane == b) myv = p; }
        if (lane < 8) dst[(size_t)lane * nstride] = myv;
    }
    __syncthreads();
}

constexpr float LOG2E = 1.4426950408889634f;
__device__ __forceinline__ float fsigmoid(float x) { return __builtin_amdgcn_rcpf(1.0f + __builtin_amdgcn_exp2f(-LOG2E * x)); }
__device__ __forceinline__ float gelu_tanh(float x) { const float u2 = 1.5957691216057308f * (x + 0.044715f * x * x * x); return x * fsigmoid(u2); }
__device__ __forceinline__ void mixer_a_item(const Args& a, const int lane, const int it) {
    const bf16_t* U = (const bf16_t*)(a.ws + WS_BIG); bf16_t* Y = (bf16_t*)(a.ws + WS_Y);
    float cw[3][8];
#pragma unroll
    for (int k = 0; k < 3; ++k)
#pragma unroll
        for (int i = 0; i < 8; ++i) cw[k][i] = a.in[6][k * 512 + 8 * lane + i];
    const size_t row0 = (size_t)it * 8; const int t0 = (int)(row0 & 4095);
    float p2[8], p1[8];
#pragma unroll
    for (int i = 0; i < 8; ++i) { p2[i] = 0.f; p1[i] = 0.f; }
    if (t0 >= 2) {
        const u32x4 c2 = *(const u32x4*)(U + (row0 - 2) * NIN + 512 + 8 * lane), x2 = *(const u32x4*)(U + (row0 - 2) * NIN + 1024 + 8 * lane);
        const u32x4 c1 = *(const u32x4*)(U + (row0 - 1) * NIN + 512 + 8 * lane), x1 = *(const u32x4*)(U + (row0 - 1) * NIN + 1024 + 8 * lane);
#pragma unroll
        for (int q = 0; q < 4; ++q) { p2[2 * q] = bflo(c2[q]) * bflo(x2[q]); p2[2 * q + 1] = bfhi(c2[q]) * bfhi(x2[q]); p1[2 * q] = bflo(c1[q]) * bflo(x1[q]); p1[2 * q + 1] = bfhi(c1[q]) * bfhi(x1[q]); }
    }
#pragma unroll
    for (int tt = 0; tt < 8; ++tt) { const size_t row = row0 + tt;
        const u32x4 ab = *(const u32x4*)(U + row * NIN + 8 * lane), ac = *(const u32x4*)(U + row * NIN + 512 + 8 * lane), ax = *(const u32x4*)(U + row * NIN + 1024 + 8 * lane);
        float p[8], y[8];
#pragma unroll
        for (int q = 0; q < 4; ++q) { p[2 * q] = bflo(ac[q]) * bflo(ax[q]); p[2 * q + 1] = bfhi(ac[q]) * bfhi(ax[q]); }
#pragma unroll
        for (int q = 0; q < 4; ++q) { y[2 * q] = bflo(ab[q]) * (cw[0][2 * q] * p2[2 * q] + cw[1][2 * q] * p1[2 * q] + cw[2][2 * q] * p[2 * q]);
            y[2 * q + 1] = bfhi(ab[q]) * (cw[0][2 * q + 1] * p2[2 * q + 1] + cw[1][2 * q + 1] * p1[2 * q + 1] + cw[2][2 * q + 1] * p[2 * q + 1]); }
        u32x4 o; o.x = cvt_pk_bf16(y[0], y[1]); o.y = cvt_pk_bf16(y[2], y[3]); o.z = cvt_pk_bf16(y[4], y[5]); o.w = cvt_pk_bf16(y[6], y[7]);
        *(u32x4*)(Y + row * D + 8 * lane) = o;
#pragma unroll
        for (int i = 0; i < 8; ++i) { p2[i] = p1[i]; p1[i] = p[i]; } }
}

__device__ __forceinline__ void scan_phase(const Args& a, unsigned char* lds) {
    const int tid = threadIdx.x, lane = tid & 63, w = tid >> 6;
    const bf16_t* U = (const bf16_t*)(a.ws + WS_BIG); bf16_t* Y = (bf16_t*)(a.ws + WS_Y);
    unsigned long long* agg = (unsigned long long*)(a.ws + WS_XR);
    unsigned* cnt = (unsigned*)(a.ws + WS_BAR) + 3456  ;
    bf16_t* Wl = (bf16_t*)lds;
    float* cw = (float*)(lds + 18432);
    unsigned char* wb = lds + 20480 + w * 16640;
    bf16_t* raw = (bf16_t*)wb;
    float* xr = (float*)(wb + 2816);
    bf16_t* hlb = (bf16_t*)(wb + 7168);
    bf16_t* acb = (bf16_t*)(wb + 11776);
    float* cy = (float*)(wb + 16384);
    const int r16 = lane & 15, kq = lane >> 4;
    const int vb = blockIdx.x, head = (vb >> 4) & 7;
    __syncthreads();
    { float tv[16];
#pragma unroll
      for (int q = 0; q < 16; ++q) { const int e = tid + 512 * q; tv[q] = (e < 4096 ? a.in[9] : a.in[11])[(size_t)head * 4096 + (e & 4095)]; }
#pragma unroll
      for (int q = 0; q < 16; ++q) { const int e = tid + 512 * q, gte = e >> 12, i = (e >> 6) & 63, jn = e & 63;
          Wl[(gte * 64 + jn) * 72 + i] = (bf16_t)(cvt_pk_bf16(tv[q], 0.f) & 0xffffu); }
      if (tid < 320) cw[tid] = tid < 256 ? a.in[7][(tid >> 6) * 512 + head * 64 + (tid & 63)] : a.in[8][head * 64 + (tid & 63)]; }
    float gba[4], gbx[4], gsp[4];
#pragma unroll
    for (int nt = 0; nt < 4; ++nt) { const int c2 = head * 64 + nt * 16 + r16; gba[nt] = a.in[10][c2] * (-LOG2E); gbx[nt] = a.in[12][c2] * (-LOG2E);
        const float lam = a.in[13][c2]; gsp[nt] = (-8.0f * LOG2E) * (fmaxf(-lam, 0.f) + log1pf(expf(-fabsf(lam)))); }
    __syncthreads();
    u32x4 pre[3];
    for (int rnd = 0; rnd < 4; ++rnd) {
        const int pair = (vb >> 4) + 16 * rnd, b = pair >> 3, seg = (vb & 15) * 8 + w, t0 = seg * 32;
        float Arun[4], Hrun[4];
#pragma unroll
        for (int nt = 0; nt < 4; ++nt) { Arun[nt] = 1.f; Hrun[nt] = 0.f; }
#define SCAN_FETCHB(BB, TC) do { _Pragma("unroll") for (int i = 0; i < 3; ++i) { const int e = lane + 64 * i, rr = e >> 3, ck = e & 7, t = (TC) - 3 + rr; pre[i] = (u32x4){0u, 0u, 0u, 0u}; \
            if (e < 19 * 8 && t >= 0) pre[i] = *(const u32x4*)(U + (size_t)((BB) * SEQ + t) * NIN + 2048 + head * 64 + ck * 8); } } while (0)
#define SCAN_FETCH(TC) SCAN_FETCHB(b, TC)
        if (rnd == 0) SCAN_FETCH(t0);
#pragma unroll
        for (int c = 0; c < 2; ++c) {
            const int tc = t0 + 16 * c;
#pragma unroll
            for (int i = 0; i < 3; ++i) { const int e = lane + 64 * i; if (e < 19 * 8) *(u32x4*)(raw + (e >> 3) * 72 + (e & 7) * 8) = pre[i]; }
            if (c < 1) SCAN_FETCH(tc + 16);
            bf16x8 af[2];
#pragma unroll
            for (int ks = 0; ks < 2; ++ks) { const int c0 = 32 * ks + 8 * kq;
                f32x4 v0 = *(const f32x4*)(cw + 256 + c0), v1 = *(const f32x4*)(cw + 256 + c0 + 4);
#pragma unroll
                for (int tap = 0; tap < 4; ++tap) { const u32x4 xq = *(const u32x4*)(raw + (r16 + tap) * 72 + c0);
                    const f32x4 w0 = *(const f32x4*)(cw + tap * 64 + c0), w1 = *(const f32x4*)(cw + tap * 64 + c0 + 4);
                    v0 = v0 + w0 * (f32x4){bflo(xq.x), bfhi(xq.x), bflo(xq.y), bfhi(xq.y)}; v1 = v1 + w1 * (f32x4){bflo(xq.z), bfhi(xq.z), bflo(xq.w), bfhi(xq.w)}; }
                *(f32x4*)(xr + r16 * 68 + c0) = v0; *(f32x4*)(xr + r16 * 68 + c0 + 4) = v1;
                u32x4 pk; pk.x = cvt_pk_bf16(v0[0], v0[1]); pk.y = cvt_pk_bf16(v0[2], v0[3]); pk.z = cvt_pk_bf16(v1[0], v1[1]); pk.w = cvt_pk_bf16(v1[2], v1[3]);
                af[ks] = __builtin_bit_cast(bf16x8, pk); }
#pragma unroll
            for (int nt = 0; nt < 4; ++nt) {
                f32x4 ca = (f32x4){0.f, 0.f, 0.f, 0.f}, cx = (f32x4){0.f, 0.f, 0.f, 0.f};
#pragma unroll
                for (int ks = 0; ks < 2; ++ks) {
                    const bf16x8 bA = *(const bf16x8*)(Wl + (nt * 16 + r16) * 72 + ks * 32 + kq * 8);
                    const bf16x8 bX = *(const bf16x8*)(Wl + (64 + nt * 16 + r16) * 72 + ks * 32 + kq * 8);
                    ca = __builtin_amdgcn_mfma_f32_16x16x32_bf16(af[ks], bA, ca, 0, 0, 0);
                    cx = __builtin_amdgcn_mfma_f32_16x16x32_bf16(af[ks], bX, cx, 0, 0, 0); }
                const int ch = nt * 16 + r16;
                float As[4], Hs[4], A = 1.f, H = 0.f;
#pragma unroll
                for (int jj = 0; jj < 4; ++jj) { const int tok = 4 * kq + jj;
                    const float r = __builtin_amdgcn_rcpf(1.0f + __builtin_amdgcn_exp2f(ca[jj] * (-LOG2E) + gba[nt]));
                    const float ig = __builtin_amdgcn_rcpf(1.0f + __builtin_amdgcn_exp2f(cx[jj] * (-LOG2E) + gbx[nt]));
                    const float a1 = __builtin_amdgcn_exp2f(r * gsp[nt]); const float xv = xr[tok * 68 + ch];
                    const float om = fmaxf(__builtin_fmaf(-a1, a1, 1.0f), 0.0f);
                    const float b1 = __builtin_amdgcn_sqrtf(om) * (ig * xv);
                    H = a1 * H + b1; A *= a1; As[jj] = A; Hs[jj] = H; }
                const float A1 = __shfl_up(A, 16), H1 = __shfl_up(H, 16), A2 = __shfl_up(A, 32), H2 = __shfl_up(H, 32), A3 = __shfl_up(A, 48), H3 = __shfl_up(H, 48);
                float ea = 1.f, eh = 0.f;
                if (kq >= 3) { ea = A3; eh = H3; }
                if (kq >= 2) { eh = A2 * eh + H2; ea *= A2; }
                if (kq >= 1) { eh = A1 * eh + H1; ea *= A1; }
                const float WA = __shfl(A * ea, 48 + r16), WH = __shfl(A * eh + H, 48 + r16);
                const float pa = ea * Arun[nt], ph = ea * Hrun[nt] + eh;
#pragma unroll
                for (int jj = 0; jj < 4; ++jj) { const int ts = 16 * c + 4 * kq + jj;
                    acb[ts * 72 + ch] = (bf16_t)(cvt_pk_bf16(As[jj] * pa, 0.f) & 0xffffu);
                    hlb[ts * 72 + ch] = (bf16_t)(cvt_pk_bf16(As[jj] * ph + Hs[jj], 0.f) & 0xffffu); }
                Hrun[nt] = WA * Hrun[nt] + WH; Arun[nt] *= WA;
            }
        }
        float2* bagg = (float2*)(lds + 20480 + 8 * 16640);
        if (kq == 0) {
#pragma unroll
            for (int nt = 0; nt < 4; ++nt) { float2 v; v.x = Arun[nt]; v.y = Hrun[nt]; bagg[w * 64 + nt * 16 + r16] = v; }
        }
        const u32x4 g0 = *(const u32x4*)(U + (size_t)(b * SEQ + t0 + (lane >> 3)) * NIN + 1536 + head * 64 + (lane & 7) * 8);
        const u32x4 g1 = *(const u32x4*)(U + (size_t)(b * SEQ + t0 + 8 + (lane >> 3)) * NIN + 1536 + head * 64 + (lane & 7) * 8);
        const u32x4 g2 = *(const u32x4*)(U + (size_t)(b * SEQ + t0 + 16 + (lane >> 3)) * NIN + 1536 + head * 64 + (lane & 7) * 8);
        const u32x4 g3 = *(const u32x4*)(U + (size_t)(b * SEQ + t0 + 24 + (lane >> 3)) * NIN + 1536 + head * 64 + (lane & 7) * 8);
        __syncthreads();
        float PA = 1.f, PH = 0.f, BA = 1.f, BH = 0.f;
#pragma unroll
        for (int ww = 0; ww < 8; ++ww) { const float2 v = bagg[ww * 64 + lane]; if (ww == w) { PA = BA; PH = BH; } BH = v.x * BH + v.y; BA *= v.x; }
        __syncthreads();
        const int blk = vb & 15;
        if (w == 0) {
            const unsigned long long v = (unsigned long long)__builtin_bit_cast(unsigned, BA) | ((unsigned long long)__builtin_bit_cast(unsigned, BH) << 32);
            __hip_atomic_store(agg + ((size_t)pair * 16 + blk) * 64 + lane, v, __ATOMIC_RELAXED, __HIP_MEMORY_SCOPE_AGENT);
            asm volatile("s_waitcnt vmcnt(0)" ::: "memory");
            if (lane == 0) __hip_atomic_fetch_add(cnt + pair * 16, 1u, __ATOMIC_RELAXED, __HIP_MEMORY_SCOPE_AGENT);
        }
        if (rnd < 2) mixer_a_item(a, lane, (int)(blockIdx.x * 8 + w) + rnd * (int)(gridDim.x * 8));
        if (rnd < 3) SCAN_FETCHB(b + 2, t0);
        if (lane == 0) { unsigned sp = 0;
            while (__hip_atomic_load(cnt + pair * 16, __ATOMIC_RELAXED, __HIP_MEMORY_SCOPE_AGENT) < 16u) { __builtin_amdgcn_s_sleep(1); if (++sp > (1u << 22)) break; } }
        { float hcar = 0.f; const unsigned long long* ap = agg + (size_t)pair * 16 * 64 + lane;
          unsigned long long q[15];
#pragma unroll
          for (int k = 0; k < 15; ++k) q[k] = __hip_atomic_load(ap + (size_t)(k < blk ? k : 0) * 64, __ATOMIC_RELAXED, __HIP_MEMORY_SCOPE_AGENT);
#pragma unroll
          for (int k = 0; k < 15; ++k) if (k < blk) hcar = __builtin_bit_cast(float, (unsigned)(q[k] & 0xffffffffull)) * hcar + __builtin_bit_cast(float, (unsigned)(q[k] >> 32));
          cy[lane] = PA * hcar + PH; }
        { const int ck = lane & 7; const f32x4 c0 = *(const f32x4*)(cy + ck * 8), c1 = *(const f32x4*)(cy + ck * 8 + 4);
#pragma unroll
          for (int q = 0; q < 4; ++q) { const int tl = 8 * q + (lane >> 3); const u32x4 gt = q == 0 ? g0 : q == 1 ? g1 : q == 2 ? g2 : g3;
              const u32x4 av = *(const u32x4*)(acb + tl * 72 + ck * 8), hv = *(const u32x4*)(hlb + tl * 72 + ck * 8);
              float y[8];
              y[0] = gelu_tanh(bflo(gt.x)) * (bflo(av.x) * c0[0] + bflo(hv.x)); y[1] = gelu_tanh(bfhi(gt.x)) * (bfhi(av.x) * c0[1] + bfhi(hv.x));
              y[2] = gelu_tanh(bflo(gt.y)) * (bflo(av.y) * c0[2] + bflo(hv.y)); y[3] = gelu_tanh(bfhi(gt.y)) * (bfhi(av.y) * c0[3] + bfhi(hv.y));
              y[4] = gelu_tanh(bflo(gt.z)) * (bflo(av.z) * c1[0] + bflo(hv.z)); y[5] = gelu_tanh(bfhi(gt.z)) * (bfhi(av.z) * c1[1] + bfhi(hv.z));
              y[6] = gelu_tanh(bflo(gt.w)) * (bflo(av.w) * c1[2] + bflo(hv.w)); y[7] = gelu_tanh(bfhi(gt.w)) * (bfhi(av.w) * c1[3] + bfhi(hv.w));
              u32x4 o; o.x = cvt_pk_bf16(y[0], y[1]); o.y = cvt_pk_bf16(y[2], y[3]); o.z = cvt_pk_bf16(y[4], y[5]); o.w = cvt_pk_bf16(y[6], y[7]);
              *(u32x4*)(Y + (size_t)(b * SEQ + t0 + tl) * D + 512 + head * 64 + ck * 8) = o; } }
    }
#undef SCAN_FETCH
#undef SCAN_FETCHB
}

__device__ __forceinline__ f32x16 attn_qk(const bf16x8 (&Kc)[4], const bf16x8 (&Qf)[4]) {
    f32x16 S;
#pragma unroll
    for (int r = 0; r < 16; ++r) S[r] = 0.f;
#pragma unroll
    for (int ks = 0; ks < 4; ++ks) S = __builtin_amdgcn_mfma_f32_32x32x16_bf16(Kc[ks], Qf[ks], S, 0, 0, 0);
    return S;
}
__device__ __forceinline__ void attn_rest(const f32x16& S, const bf16x8 (&Vc)[2][2], f32x16 (&Oa)[2], float& R, const bool diag, const int l32, const int hf) {
    float kp[16], bt[16];
#pragma unroll
    for (int r = 0; r < 16; ++r) { const float E = __builtin_amdgcn_exp2f(S[r]); const float kk = __builtin_amdgcn_rcpf(1.0f + E); kp[r] = kk; bt[r] = E * kk; }
    if (diag) {
#pragma unroll
        for (int r = 0; r < 16; ++r) { const int ko = 16 * (r >> 3) + 8 * hf + (r & 7); if (ko >= l32) { kp[r] = 1.0f; bt[r] = 0.0f; } }
    }
    float sx[16], Pm[2], Qm[2];
#pragma unroll
    for (int m = 0; m < 2; ++m) { sx[8 * m + 7] = 1.0f;
#pragma unroll
        for (int r = 6; r >= 0; --r) sx[8 * m + r] = sx[8 * m + r + 1] * kp[8 * m + r + 1];
        Pm[m] = sx[8 * m] * kp[8 * m]; Qm[m] = __shfl_xor(Pm[m], 32); }
    const float T1 = R, T0 = R * (Pm[1] * Qm[1]); R = T0 * (Pm[0] * Qm[0]);
    const float base1 = hf == 0 ? T1 * Qm[1] : T1, base0 = hf == 0 ? T0 * Qm[0] : T0;
#pragma unroll
    for (int m = 0; m < 2; ++m) { const float base = m == 0 ? base0 : base1;
        float wv[8];
#pragma unroll
        for (int i = 0; i < 8; ++i) wv[i] = bt[8 * m + i] * (sx[8 * m + i] * base);
        u32x4 pk; pk.x = cvt_pk_bf16(wv[0], wv[1]); pk.y = cvt_pk_bf16(wv[2], wv[3]); pk.z = cvt_pk_bf16(wv[4], wv[5]); pk.w = cvt_pk_bf16(wv[6], wv[7]);
        const bf16x8 pb = __builtin_bit_cast(bf16x8, pk);
#pragma unroll
        for (int dt = 0; dt < 2; ++dt) Oa[dt] = __builtin_amdgcn_mfma_f32_32x32x16_bf16(Vc[dt][m], pb, Oa[dt], 0, 0, 0);
    }
}
__device__ __forceinline__ void attn_phase(const Args& a, unsigned char* lds) {
    const int tid = threadIdx.x, lane = tid & 63, w = __builtin_amdgcn_readfirstlane(tid >> 6), l32 = lane & 31, hf = lane >> 5;
    bf16_t* ot = (bf16_t*)(lds + w * 4608);
    __builtin_amdgcn_s_setreg(1 | (4 << 6) | (1 << 11), 0);
    if (w >= 4) __builtin_amdgcn_s_setprio(1);
    const bf16_t* Qb = (const bf16_t*)(a.ws + WS_Q); const bf16_t* Kb = (const bf16_t*)(a.ws + WS_K); const bf16_t* Vt = (const bf16_t*)(a.ws + WS_VT);
    bf16_t* O = (bf16_t*)(a.ws + WS_Y);
    const int vb = (gridDim.x % 8 == 0) ? (int)(blockIdx.x % 8) * (int)(gridDim.x / 8) + (int)(blockIdx.x / 8) : (int)blockIdx.x;
    const int gw = vb * 8 + w, NGW = gridDim.x * 8;
    for (int unit = gw; unit < 8192; unit += NGW) {
        const int bh = unit >> 6, qg = unit & 63, b = bh >> 4, hh = bh & 15;
        const int qw = qg * 64;
        const bf16_t* Qg = Qb + (size_t)bh * 128 * 2048 + lane * 8;
        const bf16_t* Kg = Kb + (size_t)bh * 128 * 2048 + lane * 8;
        const bf16_t* Vg = Vt + (size_t)bh * 128 * 2048 + lane * 8;
        bf16x8 Qf0[4], Qf1[4];
#pragma unroll
        for (int ks = 0; ks < 4; ++ks) { Qf0[ks] = *(const bf16x8*)(Qg + (size_t)(qw >> 5) * 2048 + ks * 512);
            Qf1[ks] = *(const bf16x8*)(Qg + (size_t)((qw >> 5) + 1) * 2048 + ks * 512); }
        f32x16 Oa0[2], Oa1[2];
#pragma unroll
        for (int r = 0; r < 16; ++r) { Oa0[0][r] = 0.f; Oa0[1][r] = 0.f; Oa1[0][r] = 0.f; Oa1[1][r] = 0.f; }
        float R0 = 1.0f, R1 = 1.0f;
        int kb = qw + 32;
        bf16x8 Ka[4], Va[2][2], Kz[4], Vz[2][2];
#define ATT_LDK(Kx, blk) do { _Pragma("unroll") for (int ks = 0; ks < 4; ++ks) Kx[ks] = *(const bf16x8*)(Kg + (size_t)(blk) * 2048 + ks * 512); } while (0)
#define ATT_LDV(Vx, blk) do { _Pragma("unroll") for (int dt = 0; dt < 2; ++dt) _Pragma("unroll") for (int m = 0; m < 2; ++m) Vx[dt][m] = *(const bf16x8*)(Vg + (size_t)(blk) * 2048 + (dt * 2 + m) * 512); } while (0)
#define ATT_ITER(Kx, Vx) { \
            const bool first = kb > qw;                         \
            const f32x16 S1 = attn_qk(Kx, Qf1); f32x16 S0; if (!first) S0 = attn_qk(Kx, Qf0); \
            if (kb >= 64) ATT_LDK(Kx, (kb >> 5) - 2); \
            attn_rest(S1, Vx, Oa1, R1, first, l32, hf);         \
            if (!first) attn_rest(S0, Vx, Oa0, R0, kb == qw, l32, hf); \
            if (kb == 0) break; \
            if (__builtin_amdgcn_ballot_w64(R0 != 0.0f || R1 != 0.0f) == 0ull) break; \
            if (kb >= 64) ATT_LDV(Vx, (kb >> 5) - 2); \
            kb -= 32; }
        ATT_LDK(Ka, kb >> 5); ATT_LDV(Va, kb >> 5); ATT_LDK(Kz, (kb >> 5) - 1); ATT_LDV(Vz, (kb >> 5) - 1);
        for (;;) { ATT_ITER(Ka, Va) ATT_ITER(Kz, Vz) }
#undef ATT_ITER
#undef ATT_LDK
#undef ATT_LDV
#pragma unroll
        for (int st = 0; st < 2; ++st) {
#pragma unroll
            for (int dt = 0; dt < 2; ++dt)
#pragma unroll
                for (int g = 0; g < 4; ++g) { const f32x16& oo = st == 0 ? Oa0[dt] : Oa1[dt];
                    u32x2 o; o.x = cvt_pk_bf16(oo[4 * g], oo[4 * g + 1]); o.y = cvt_pk_bf16(oo[4 * g + 2], oo[4 * g + 3]);
                    *(u32x2*)(ot + l32 * 72 + 32 * dt + 8 * g + 4 * hf) = o; }
#pragma unroll
            for (int i = 0; i < 4; ++i) { const int row = 8 * i + (lane >> 3), ck = lane & 7;
                const u32x4 v = *(const u32x4*)(ot + row * 72 + ck * 8);
                *(u32x4*)(O + (size_t)(b * SEQ + qw + 32 * st + row) * D + hh * HD + ck * 8) = v; }
        }
    }
    __builtin_amdgcn_s_setprio(0);
    __builtin_amdgcn_s_setreg(1 | (4 << 6) | (1 << 11), 3);
}

#define XB_TMO      128
#define XB_XCNT(j)  (256  + 64 * (j))
#define XB_XSUB(j)  (1280 + 64 * (j))
#define XB_XGEN(j)  (2304 + 64 * (j))
#define XB_TOP      3328
#define XB_TOPGEN   3392
#define XCD_BAR_WORDS 3456
#define XB_SPIN_CAP (1u << 18)
__device__ __forceinline__ unsigned xb_ld(unsigned* p)              { return __hip_atomic_load(p, __ATOMIC_RELAXED, __HIP_MEMORY_SCOPE_AGENT); }
__device__ __forceinline__ unsigned xb_add(unsigned* p, unsigned v) { return __hip_atomic_fetch_add(p, v, __ATOMIC_RELAXED, __HIP_MEMORY_SCOPE_AGENT); }
__device__ __forceinline__ unsigned xb_xcc_id() { return (unsigned)__builtin_amdgcn_s_getreg((3 << 11) | 20) & 0xFu; }
#define XB_SPIN(cond, bar) do { unsigned _sp = 0; while (cond) { __builtin_amdgcn_s_sleep(1); \
    if ((++_sp & 255u) == 0u) { if (xb_ld(&(bar)[XB_TMO])) break; if (_sp > XB_SPIN_CAP) { atomicAdd(&(bar)[XB_TMO], 1u); break; } } } } while (0)
struct XcdBarrier { unsigned* bar; unsigned x; volatile LAS unsigned* st; };
__device__ __forceinline__ XcdBarrier xcd_barrier_post(unsigned* bar, volatile LAS unsigned* st) {
    XcdBarrier b; b.bar = bar; b.x = xb_xcc_id(); b.st = st;
    if (threadIdx.x == 0) (void)xb_add(&bar[XB_XCNT(b.x)], 1u);
    return b;
}
__device__ __forceinline__ void xcd_barrier_complete(unsigned* bar, unsigned x, unsigned& nloc, unsigned& nx) {
    const unsigned G = gridDim.x * gridDim.y * gridDim.z;
    unsigned sum, cnt, mine, sp = 0u;
    for (;;) {
        sum = 0u; cnt = 0u; mine = 0u;
#pragma unroll
        for (unsigned j = 0; j < 16; ++j) { const unsigned c = xb_ld(&bar[XB_XCNT(j)]); sum += c; cnt += (c > 0u) ? 1u : 0u; mine = (j == x) ? c : mine; }
        if (sum == G) break;
        __builtin_amdgcn_s_sleep(1);
        if ((++sp & 255u) == 0u) { if (xb_ld(&bar[XB_TMO])) break; if (sp > XB_SPIN_CAP) { atomicAdd(&bar[XB_TMO], 1u); break; } }
    }
    nloc = mine > 0u ? mine : 1u; nx = cnt > 0u ? cnt : 1u;
}
__device__ __forceinline__ void xcd_barrier(const XcdBarrier& b) {
    asm volatile("s_waitcnt vmcnt(0)" ::: "memory");
    __syncthreads();
    if (threadIdx.x == 0) {
        unsigned* bar = b.bar;
        __builtin_amdgcn_s_waitcnt(0);
        unsigned nloc = b.st[0], nx = b.st[1];
        if (nloc == 0u) { xcd_barrier_complete(bar, b.x, nloc, nx); b.st[0] = nloc; b.st[1] = nx; }
        const unsigned old = xb_add(&bar[XB_XSUB(b.x)], 1u);
        const unsigned gen = old / nloc;
        if (old + 1u == (gen + 1u) * nloc) {
            __builtin_amdgcn_fence(__ATOMIC_RELEASE, "agent");
            asm volatile("s_waitcnt vmcnt(0)" ::: "memory");
            const unsigned og = xb_add(&bar[XB_TOP], 1u);
            const unsigned tg = og / nx;
            if (og + 1u == (tg + 1u) * nx) xb_add(&bar[XB_TOPGEN], 1u);
            else XB_SPIN(xb_ld(&bar[XB_TOPGEN]) == tg, bar);
            __builtin_amdgcn_fence(__ATOMIC_ACQUIRE, "agent");
            xb_add(&bar[XB_XGEN(b.x)], 1u);
            asm volatile("s_waitcnt vmcnt(0)" ::: "memory");
        } else {
            XB_SPIN(xb_ld(&bar[XB_XGEN(b.x)]) == gen, bar);
            __builtin_amdgcn_fence(__ATOMIC_ACQUIRE, "agent");
            asm volatile("s_waitcnt vmcnt(0)" ::: "memory");
        }
    }
    __syncthreads();
}

template <int PH, bool DUMMY = false> __device__ __forceinline__ void run_phase(const Args& a, unsigned char* lds) {
    float* mod = (float*)(a.ws + WS_MOD);
    bf16_t* H = (bf16_t*)(a.ws + WS_H); bf16_t* Y = (bf16_t*)(a.ws + WS_Y); bf16_t* BIG = (bf16_t*)(a.ws + WS_BIG);
    float* rowss = (float*)(a.ws + WS_ROWSS); const float* gsv = (const float*)(a.ws + WS_GSV); const float* rgsv = gsv + 3 * 8 * D; const float* cvec = (const float*)(a.ws + WS_CVEC);
    PG8_LAS unsigned char* glds = (PG8_LAS unsigned char*)lds;
    constexpr int l = PH >= 9 ? 1 : 0;
    if constexpr (PH == 0) {
        p0_prologue(a, lds);
    } else if constexpr (PH == 1) {
        norm_phase(a.in[0], a.in[4], mod, mod + D, H);
        p1_extras(a, lds);
    } else if constexpr (PH == 2) {
        pg8::Gemm g{H, (const bf16_t*)(a.ws + WS_WIN), M, NIN, D}; pg8::EpiBf16 E{BIG, NIN};
        pg8::StaticOrder S; S.init(M, NIN, gridDim.x, blockIdx.x);
        pg8::gemm_phase<pg8::EpiBf16, pg8::StaticOrder, true, true>(glds, g, S, E);
    } else if constexpr (PH == 10) {
        { pg8::Gemm g{H, (const bf16_t*)(a.ws + WS_WQK), M, NQK, D}; pg8::StaticOrder S; S.init(M, NQK, gridDim.x, blockIdx.x);
          pg8::EpiQK E{(bf16_t*)(a.ws + WS_Q), (bf16_t*)(a.ws + WS_K), a.in[23], a.in[24], rowss + M, cvec + CV_QK};
          pg8::gemm_phase<pg8::EpiQK, pg8::StaticOrder, true, true>(glds, g, S, E); }
        { pg8::Gemm g{(const bf16_t*)(a.ws + WS_WV), H, D, M, D}; pg8::EpiVt E{(bf16_t*)(a.ws + WS_VT), rowss + M, cvec + CV_V};
          pg8::StaticOrder S; S.init(D, M, gridDim.x, blockIdx.x);
          pg8::gemm_phase<pg8::EpiVt, pg8::StaticOrder, true, true>(glds, g, S, E); }
    } else if constexpr (PH == 3) {
        scan_phase(a, lds);
    } else if constexpr (PH == 5 || PH == 12) {
        constexpr int nrm = PH == 5 ? 0 : 2;
        pg8::Gemm g{Y, (const bf16_t*)(a.ws + (PH == 5 ? WS_WO0 : WS_WO1)), M, D, D};
        typedef pg8::EpiRes<true, PH != 5, false> EpiT;
        bf16_t* dmy = (bf16_t*)(a.ws + 442 * MiB); float* dmr = (float*)(a.ws + 506 * MiB);
        EpiT E{PH == 5 ? (const void*)a.in[0] : (const void*)H, nullptr, mod + (size_t)l * 8 * NMOD + 2 * D, DUMMY ? dmy : H, gsv + nrm * 8 * D, DUMMY ? dmr : rowss + (size_t)nrm * M, rgsv + 1 * 8 * D};
        pg8::StaticOrder S; S.init(M, D, gridDim.x, blockIdx.x);
        pg8::gemm_phase<EpiT, pg8::StaticOrder, true, true>(glds, g, S, E);
    } else if constexpr (PH == 8) {
        pg8::Gemm g{BIG, (const bf16_t*)(a.ws + WS_WD0), M, D, FF};
        typedef pg8::EpiRes<true, true, false> EpiT;
        bf16_t* dmy = (bf16_t*)(a.ws + 442 * MiB); float* dmr = (float*)(a.ws + 506 * MiB);
        EpiT E{H, nullptr, mod + 5 * D, DUMMY ? dmy : H, gsv + 1 * 8 * D, DUMMY ? dmr : rowss + (size_t)1 * M, rgsv + 0 * 8 * D};
        pg8::StaticOrder S; S.init(M, D, gridDim.x, blockIdx.x);
        pg8::gemm_phase<EpiT, pg8::StaticOrder, true, true>(glds, g, S, E);
    } else if constexpr (PH == 15) {
        pg8::Gemm g{BIG, (const bf16_t*)(a.ws + WS_WD1), M, D, FF};
        typedef pg8::EpiRes<false, true, true> EpiT;
        EpiT E{H, a.out, mod + (size_t)8 * NMOD + 5 * D, nullptr, nullptr, nullptr, rgsv + 2 * 8 * D};
        pg8::StaticOrder S; S.init(M, D, gridDim.x, blockIdx.x);
        pg8::gemm_phase<EpiT, pg8::StaticOrder, true, true>(glds, g, S, E);
    } else if constexpr (PH == 7 || PH == 14) {
        pg8::Gemm g{H, (const bf16_t*)(a.ws + (PH == 7 ? WS_WGU0 : WS_WGU1)), M, NGU, D};
        pg8::EpiSwiGLU E{BIG, rowss + (size_t)(PH == 7 ? 0 : 2) * M, cvec + (PH == 7 ? CV_GU0 : CV_GU1)};
        pg8::StaticOrder S; S.init(M, NGU, gridDim.x, blockIdx.x);
        pg8::gemm_phase<pg8::EpiSwiGLU, pg8::StaticOrder, true, true>(glds, g, S, E);
    } else if constexpr (PH == 11) {
        attn_phase(a, lds);
    }
}
__global__ void __launch_bounds__(512, 2) fwd_megakernel(Args a) {
    extern __shared__ __attribute__((aligned(16))) unsigned char lds[];
    volatile LAS unsigned* misc = (volatile LAS unsigned*)((LAS unsigned char*)lds + MISC_OFF);
    XcdBarrier xbar; xbar.bar = (unsigned*)(a.ws + WS_BAR); xbar.x = 0; xbar.st = misc;
    if (a.coop) {
        if (threadIdx.x < 2) misc[threadIdx.x] = 0u;
        __syncthreads();
        xbar = xcd_barrier_post((unsigned*)(a.ws + WS_BAR), misc);
    }
#ifndef DUP_MASK
#define DUP_MASK 0
#endif
    if (a.pad) cg::this_grid().sync();
#define SEAM(k) xcd_barrier(xbar)
#define PHASE(k) if (EN(k) && a.ph_lo <= (k) && (k) < a.ph_hi) { if ((DUP_MASK >> (k)) & 1) { run_phase<k, true>(a, lds); SEAM(k); } run_phase<k>(a, lds); if ((k) + 1 < a.ph_hi && a.coop) SEAM(k); }
    PHASE(0) PHASE(1) PHASE(2) PHASE(3) PHASE(5) PHASE(7) PHASE(8) PHASE(10) PHASE(11) PHASE(12) PHASE(14) PHASE(15)
#undef PHASE
#undef SEAM
}

extern "C" void kernel_launch(void* const* d_in, const int* in_sizes, int n_in, void* d_out, int out_size, void* d_ws, size_t ws_size, hipStream_t stream) {
    static int grid = 0;
    if (grid == 0) {
        if (n_in != 30 || out_size != M * D || ws_size < WS_END) { fprintf(stderr, "kernel_launch: unexpected shapes (n_in %d out %d ws %zu)\n", n_in, out_size, ws_size); grid = -1; return; }
        int dev = 0, cus = 0, per_cu = 0;
        (void)hipGetDevice(&dev); (void)hipDeviceGetAttribute(&cus, hipDeviceAttributeMultiprocessorCount, dev);
        if (hipFuncSetAttribute((const void*)fwd_megakernel, hipFuncAttributeMaxDynamicSharedMemorySize, LDS_BYTES) != hipSuccess) { fprintf(stderr, "kernel_launch: hipFuncSetAttribute failed\n"); grid = -1; return; }
        if (hipOccupancyMaxActiveBlocksPerMultiprocessor(&per_cu, (const void*)fwd_megakernel, 512, LDS_BYTES) != hipSuccess || per_cu < 1) { fprintf(stderr, "kernel_launch: occupancy query gave %d\n", per_cu); per_cu = 1; }
        (void)hipGetLastError();
        if (cus < 256) { fprintf(stderr, "kernel_launch: needs 256 CUs (found %d)\n", cus); grid = -1; return; }
        grid = 256;
    }
    if (grid < 0) return;
    Args a{};
    for (int i = 0; i < 30; ++i) a.in[i] = (const float*)d_in[i];
    a.out = (float*)d_out; a.ws = (unsigned char*)d_ws;
#if MK_ONE_LAUNCH
    a.ph_lo = 0; a.ph_hi = NPHASE; a.coop = 1;
    if (hipMemsetAsync((char*)d_ws + WS_BAR, 0, XCD_BAR_WORDS * 4 + 64 * 16 * 4, stream) != hipSuccess) { fprintf(stderr, "kernel_launch: memset of the barrier words failed\n"); return; }
    void* args[] = {&a};
    hipError_t e = hipLaunchCooperativeKernel((const void*)fwd_megakernel, dim3(grid), dim3(512), args, LDS_BYTES, stream);
    if (e != hipSuccess) fprintf(stderr, "cooperative launch failed: %s (grid %d)\n", hipGetErrorString(e), grid);
#else
    for (int ph = 0; ph < NPHASE; ++ph) {
        a.ph_lo = ph; a.ph_hi = ph + 1; a.coop = 0;
        hipLaunchKernelGGL(fwd_megakernel, dim3(grid), dim3(512), LDS_BYTES, stream, a);
    }
#endif
}
```

```cpp
#include <hip/hip_runtime.h>
#include <hip/hip_cooperative_groups.h>
#include <cstdio>
#include <cstdint>
namespace cg = cooperative_groups;

#ifndef PH_MASK
#define PH_MASK 0xffff
#endif
#define EN(k) (((PH_MASK) >> (k)) & 1)
#ifndef MK_ONE_LAUNCH
#define MK_ONE_LAUNCH 1
#endif

#define LAS __attribute__((address_space(3)))
typedef unsigned short bf16_t;
typedef short bf16x8 __attribute__((ext_vector_type(8)));
typedef short s16x4 __attribute__((ext_vector_type(4)));
typedef float f32x4 __attribute__((ext_vector_type(4)));
typedef float f32x16 __attribute__((ext_vector_type(16)));
typedef unsigned u32x4 __attribute__((ext_vector_type(4)));
typedef unsigned u32x2 __attribute__((ext_vector_type(2)));

constexpr int BATCH = 8, SEQ = 4096, D = 1024, M = BATCH * SEQ, NIN = 2560, FF = 2816, NGU = 2 * FF, NQK = 2048, NMOD = 6 * D;
constexpr int NHEAD = 16, HD = 64;
constexpr float EPS = 1e-6f;
constexpr size_t MiB = 1u << 20;
constexpr size_t WS_MOD = 0, WS_BAR = 768 * 1024, WS_AGG = 1 * MiB, WS_WIN = 2 * MiB, WS_WO0 = 7 * MiB, WS_WGU0 = 9 * MiB, WS_WD0 = 20 * MiB, WS_WQK = 26 * MiB, WS_WV = 30 * MiB,
                 WS_WO1 = 32 * MiB, WS_WGU1 = 34 * MiB, WS_WD1 = 45 * MiB, WS_H = 52 * MiB, WS_Y = 116 * MiB, WS_BIG = 180 * MiB, WS_XR = 372 * MiB, WS_END = 436 * MiB;
constexpr size_t WS_ROWSS = 50 * MiB + 512 * 1024, WS_GSV = WS_ROWSS + 384 * 1024, WS_CVEC = 51 * MiB + 256 * 1024;
constexpr int CV_GU0 = 0, CV_QK = 8 * NGU, CV_V = CV_QK + 8 * NQK, CV_GU1 = CV_V + 8 * D;
constexpr size_t WS_Q = WS_BIG, WS_K = WS_BIG + 64 * MiB, WS_VT = WS_BIG + 128 * MiB;
constexpr int LDS_BYTES = 158 * 1024;
constexpr int MISC_OFF = LDS_BYTES - 64;
constexpr int NPHASE = 16;

typedef float f32x2_t __attribute__((ext_vector_type(2)));
typedef __bf16 bf16x2_t __attribute__((ext_vector_type(2)));
__device__ __forceinline__ unsigned cvt_pk_bf16(float lo, float hi) { const f32x2_t v = {lo, hi}; const bf16x2_t b = __builtin_convertvector(v, bf16x2_t); return __builtin_bit_cast(unsigned, b); }
__device__ __forceinline__ float bf2f(unsigned short h) { return __builtin_bit_cast(float, (unsigned)h << 16); }
__device__ __forceinline__ float bflo(unsigned u) { return __builtin_bit_cast(float, u << 16); }
__device__ __forceinline__ float bfhi(unsigned u) { return __builtin_bit_cast(float, u & 0xffff0000u); }
__device__ __forceinline__ float wave_sum(float v) {
#pragma unroll
    for (int o = 1; o < 64; o <<= 1) v += __shfl_xor(v, o);
    return v;
}

namespace pg8 {
#define PG8_LAS __attribute__((address_space(3)))
constexpr int BM = 256, BK = 64, HALF = 128, HTB = HALF * BK * 2, STAGE_BYTES = 8 * HTB, NXCD = 8, WGM = 8;
__host__ __device__ __forceinline__ int lds_byte(int r, int c) { const int st = (r >> 4) * 2 + (c >> 5), rr = r & 15, cc = c & 31, ob = rr * 64 + cc * 2; return st * 1024 + (ob ^ (((ob >> 9) & 1) << 5)); }
__host__ __device__ __forceinline__ void stage_rc(int b, int& R, int& C) { const int st = b / 1024, sb = b % 1024, swz = sb ^ (((sb >> 9) & 1) << 5); R = (st >> 1) * 16 + swz / 64; C = (st & 1) * 32 + (swz % 64) / 2; }
__host__ __device__ __forceinline__ int perm32(int rho) { const int n = rho >> 4, i = rho & 15; return 8 * (i >> 2) + 4 * n + (i & 3); }
struct Unit { int pm, pn; };
struct Gemm { const bf16_t* A; const bf16_t* Bt; int M, N, K; };
struct StaticOrder {
    int nM, nN, nwg, G, c;
    __host__ __device__ void init(int M, int N, int G_, int c_) { nM = M / BM; nN = N / BM; nwg = nM * nN; G = G_; c = c_; }
    __host__ __device__ bool next(int i, Unit& u) const {
        const long L = (long)i * G + c; if (L >= nwg) return false;
        int wgid = (int)L; { const int q = nwg / NXCD, r = nwg % NXCD, xcd = wgid % NXCD, off = wgid / NXCD; wgid = (xcd < r ? xcd * (q + 1) : r * (q + 1) + (xcd - r) * q) + off; }
        const int nig = WGM * nN, gid = wgid / nig, fm = gid * WGM, gsz = (nM - fm) < WGM ? (nM - fm) : WGM;
        u.pm = fm + ((wgid % nig) % gsz); u.pn = (wgid % nig) / gsz; return true;
    }
    __device__ __forceinline__ void a_ready(const Unit&) const {}
    __device__ __forceinline__ void done(const Unit&) const {}
};

template <class Epi, class Sched, bool ALIGN_EPI = false, bool SP2 = false>
__device__ __forceinline__ void gemm_phase(PG8_LAS unsigned char* lds, const Gemm g, const Sched& S, const Epi& E) {
    const int tid = threadIdx.x, wid = __builtin_amdgcn_readfirstlane(tid >> 6), lane = tid & 63, wr = wid >> 2, wc = wid & 3, fr = lane & 15, fq = lane >> 4;
    const int K = g.K, nt = K / BK;
    unsigned voffA[2], voffB[2];
#pragma unroll
    for (int i = 0; i < 2; ++i) { int R, C; stage_rc(tid * 16 + i * 8192, R, C); const int Rb = Epi::PERM ? ((R & ~31) + perm32(R & 31)) : R;
        voffA[i] = (unsigned)(R * K + C) * 2u; voffB[i] = (unsigned)(Rb * K + C) * 2u; }
    const size_t kstep = (size_t)(BK * 2);
    const size_t hstep = (size_t)HALF * K * 2;
    const size_t tstep = 2 * hstep;
    const unsigned ldsw = (unsigned)wid * 1024u;
    const int aoff = lds_byte(wr * 64 + fr, fq * 8), boff = lds_byte(wc * 32 + fr, fq * 8);
#define PG8_SA(b, h) (((b) * 2 + (h)) * HTB)
#define PG8_SB(b, h) ((4 + (b) * 2 + (h)) * HTB)
#define PG8_STAGE(bufoff, gbase, voff) do { _Pragma("unroll") for (int _i = 0; _i < 2; ++_i) \
        __builtin_amdgcn_global_load_lds((const unsigned*)((const char*)(gbase) + (voff)[_i]), (PG8_LAS unsigned*)(lds + (bufoff) + ldsw + _i * 8192), 16, 0, 0); } while (0)
#define PG8_LDA(dst, b, h) do { _Pragma("unroll") for (int m = 0; m < 4; ++m) _Pragma("unroll") for (int k = 0; k < 2; ++k) dst[m][k] = *(const PG8_LAS bf16x8*)(lds + PG8_SA(b, h) + aoff + m * 2048 + k * 1024); } while (0)
#define PG8_LDB(dst, b, h) do { _Pragma("unroll") for (int n = 0; n < 2; ++n) _Pragma("unroll") for (int k = 0; k < 2; ++k) dst[n][k] = *(const PG8_LAS bf16x8*)(lds + PG8_SB(b, h) + boff + n * 2048 + k * 1024); } while (0)
#define PG8_MMA(ai, bj, At, Bt) do { __builtin_amdgcn_s_setprio(1); _Pragma("unroll") for (int m = 0; m < 4; ++m) _Pragma("unroll") for (int n = 0; n < 2; ++n) _Pragma("unroll") for (int k = 0; k < 2; ++k) \
        acc[ai][bj][m][n] = __builtin_amdgcn_mfma_f32_16x16x32_bf16(Bt[n][k], At[m][k], acc[ai][bj][m][n], 0, 0, 0); __builtin_amdgcn_s_setprio(0); } while (0)
#define PG8_WAIT_V(n) asm volatile("s_waitcnt vmcnt(" #n ")" ::: "memory")
#define PG8_WAIT_L(n) asm volatile("s_waitcnt lgkmcnt(" #n ")" ::: "memory")
#define PG8_BAR __builtin_amdgcn_s_barrier()
#define PG8_SCHED __builtin_amdgcn_sched_barrier(0)
    Unit cur, nxt; int ui = 0;
    if (!S.next(0, cur)) return;
    f32x4 acc[2][2][4][2];
#pragma unroll
    for (int a = 0; a < 2; ++a)
#pragma unroll
        for (int b = 0; b < 2; ++b)
#pragma unroll
            for (int m = 0; m < 4; ++m)
#pragma unroll
                for (int n = 0; n < 2; ++n) acc[a][b][m][n] = (f32x4){0.f, 0.f, 0.f, 0.f};
    bf16x8 At[4][2], B0[2][2], B1[2][2];
    const char* cA = (const char*)g.A + (size_t)cur.pm * tstep; const char* cB = (const char*)g.Bt + (size_t)cur.pn * tstep;
    S.a_ready(cur);
    if constexpr (SP2) {
        PG8_STAGE(PG8_SB(0, 0), cB, voffB); PG8_STAGE(PG8_SB(0, 1), cB + hstep, voffB); PG8_STAGE(PG8_SA(0, 0), cA, voffA); PG8_STAGE(PG8_SA(0, 1), cA + hstep, voffA);
        if (wr == 1) PG8_BAR;
        PG8_WAIT_V(2); PG8_BAR;
        PG8_STAGE(PG8_SB(1, 0), cB + kstep, voffB); PG8_STAGE(PG8_SA(1, 0), cA + kstep, voffA); PG8_STAGE(PG8_SB(1, 1), cB + hstep + kstep, voffB);
        PG8_WAIT_V(6); PG8_BAR;
    } else {
        PG8_STAGE(PG8_SB(0, 0), cB, voffB); PG8_STAGE(PG8_SA(0, 0), cA, voffA); PG8_STAGE(PG8_SB(0, 1), cB + hstep, voffB); PG8_STAGE(PG8_SA(0, 1), cA + hstep, voffA);
        if (wr == 1) PG8_BAR;
        PG8_WAIT_V(4); PG8_BAR;
        PG8_STAGE(PG8_SB(1, 0), cB + kstep, voffB); PG8_STAGE(PG8_SA(1, 0), cA + kstep, voffA); PG8_STAGE(PG8_SB(1, 1), cB + hstep + kstep, voffB);
        PG8_WAIT_V(6); PG8_BAR;
    }
    for (;;) {
        const bool has_next = S.next(ui + 1, nxt);
        const char* nA = has_next ? (const char*)g.A + (size_t)nxt.pm * tstep : cA; const char* nB = has_next ? (const char*)g.Bt + (size_t)nxt.pn * tstep : cB;
        for (int t = 0; t < nt; t += 2) {
            const bool last = (t == nt - 2);
            const char* a1 = cA + (size_t)(t + 1) * kstep;
            const char* a2 = last ? nA : cA + (size_t)(t + 2) * kstep; const char* b2 = last ? nB : cB + (size_t)(t + 2) * kstep;
            const char* a3 = a2 + kstep; const char* b3 = b2 + kstep;
            if (last && has_next) S.a_ready(nxt);
            if constexpr (SP2) {
            PG8_LDB(B0, 0, 0); PG8_LDB(B1, 0, 1); PG8_SCHED; PG8_LDA(At, 0, 0); PG8_STAGE(PG8_SA(1, 1), a1 + hstep, voffA);
            PG8_WAIT_V(8); PG8_WAIT_L(0); PG8_BAR; PG8_MMA(0, 0, At, B0); PG8_MMA(0, 1, At, B1); PG8_BAR; PG8_SCHED;
            PG8_LDA(At, 0, 1); PG8_STAGE(PG8_SB(0, 0), b2, voffB); PG8_STAGE(PG8_SB(0, 1), b2 + hstep, voffB); PG8_STAGE(PG8_SA(0, 0), a2, voffA);
            PG8_WAIT_V(8); PG8_WAIT_L(0); PG8_BAR; PG8_MMA(1, 0, At, B0); PG8_MMA(1, 1, At, B1); PG8_BAR; PG8_SCHED;
            PG8_LDB(B0, 1, 0); PG8_LDB(B1, 1, 1); PG8_SCHED; PG8_LDA(At, 1, 0); PG8_STAGE(PG8_SA(0, 1), a2 + hstep, voffA);
            PG8_WAIT_V(8); PG8_WAIT_L(0); PG8_BAR; PG8_MMA(0, 0, At, B0); PG8_MMA(0, 1, At, B1); PG8_BAR; PG8_SCHED;
            PG8_LDA(At, 1, 1); PG8_STAGE(PG8_SB(1, 0), b3, voffB); PG8_STAGE(PG8_SB(1, 1), b3 + hstep, voffB); PG8_STAGE(PG8_SA(1, 0), a3, voffA);
            PG8_WAIT_V(8); PG8_WAIT_L(0); PG8_BAR; PG8_MMA(1, 0, At, B0); PG8_MMA(1, 1, At, B1); PG8_BAR; PG8_SCHED;
            } else {
            PG8_LDB(B0, 0, 0); PG8_SCHED; PG8_LDA(At, 0, 0); PG8_STAGE(PG8_SA(1, 1), a1 + hstep, voffA);
            PG8_WAIT_L(8); PG8_BAR; PG8_WAIT_L(0); PG8_MMA(0, 0, At, B0); PG8_BAR; PG8_SCHED;
            PG8_LDB(B1, 0, 1); PG8_STAGE(PG8_SB(0, 0), b2, voffB);
            PG8_BAR; PG8_WAIT_L(0); PG8_MMA(0, 1, At, B1); PG8_BAR;
            PG8_LDA(At, 0, 1); PG8_STAGE(PG8_SA(0, 0), a2, voffA);
            PG8_BAR; PG8_WAIT_L(0); PG8_MMA(1, 0, At, B0); PG8_BAR; PG8_SCHED;
            PG8_STAGE(PG8_SB(0, 1), b2 + hstep, voffB);
            PG8_WAIT_V(6); PG8_BAR; PG8_MMA(1, 1, At, B1); PG8_BAR;
            PG8_LDB(B0, 1, 0); PG8_SCHED; PG8_LDA(At, 1, 0); PG8_STAGE(PG8_SA(0, 1), a2 + hstep, voffA);
            PG8_WAIT_L(8); PG8_BAR; PG8_WAIT_L(0); PG8_MMA(0, 0, At, B0); PG8_BAR; PG8_SCHED;
            PG8_LDB(B1, 1, 1); PG8_STAGE(PG8_SB(1, 0), b3, voffB);
            PG8_BAR; PG8_WAIT_L(0); PG8_MMA(0, 1, At, B1); PG8_BAR;
            PG8_LDA(At, 1, 1); PG8_STAGE(PG8_SA(1, 0), a3, voffA);
            PG8_BAR; PG8_WAIT_L(0); PG8_MMA(1, 0, At, B0); PG8_BAR; PG8_SCHED;
            PG8_STAGE(PG8_SB(1, 1), b3 + hstep, voffB);
            PG8_WAIT_V(6); PG8_BAR; PG8_MMA(1, 1, At, B1); PG8_BAR;
            }
        }
        if constexpr (ALIGN_EPI) { if (wr == 0) PG8_BAR; }
        E(acc, cur, wr, wc, fr, fq); S.done(cur);
        if (!has_next) break;
#pragma unroll
        for (int a = 0; a < 2; ++a)
#pragma unroll
            for (int b = 0; b < 2; ++b)
#pragma unroll
                for (int m = 0; m < 4; ++m)
#pragma unroll
                    for (int n = 0; n < 2; ++n) acc[a][b][m][n] = (f32x4){0.f, 0.f, 0.f, 0.f};
        cur = nxt; cA = nA; cB = nB; ++ui;
        if constexpr (ALIGN_EPI) { if (wr == 1) PG8_BAR; }
    }
    PG8_WAIT_V(0);
    if constexpr (!ALIGN_EPI) { if (wr == 0) PG8_BAR; }
    PG8_BAR;
#undef PG8_SA
#undef PG8_SB
#undef PG8_STAGE
#undef PG8_LDA
#undef PG8_LDB
#undef PG8_MMA
#undef PG8_WAIT_V
#undef PG8_WAIT_L
#undef PG8_BAR
#undef PG8_SCHED
}

struct EpiBf16 {
    static constexpr bool PERM = true;
    bf16_t* O; int ldc;
    __device__ __forceinline__ void operator()(const f32x4 (&acc)[2][2][4][2], const Unit& u, int wr, int wc, int fr, int fq) const {
        const int row0 = u.pm * BM + wr * 64 + fr, col0 = u.pn * BM + wc * 32 + 8 * fq;
#pragma unroll
        for (int ai = 0; ai < 2; ++ai)
#pragma unroll
            for (int m = 0; m < 4; ++m) { bf16_t* rowp = O + (size_t)(row0 + ai * HALF + m * 16) * ldc + col0;
#pragma unroll
                for (int bj = 0; bj < 2; ++bj) { const f32x4 v0 = acc[ai][bj][m][0], v1 = acc[ai][bj][m][1];
                    u32x4 w; w.x = cvt_pk_bf16(v0[0], v0[1]); w.y = cvt_pk_bf16(v0[2], v0[3]); w.z = cvt_pk_bf16(v1[0], v1[1]); w.w = cvt_pk_bf16(v1[2], v1[3]);
                    *(u32x4*)(rowp + bj * HALF) = w; } }
    }
};
struct EpiVt {
    static constexpr bool PERM = true;
    bf16_t* O; const float* rowss; const float* cvec;
    __device__ __forceinline__ void operator()(const f32x4 (&acc)[2][2][4][2], const Unit& u, int wr, int wc, int fr, int fq) const {
        const int row0 = u.pm * BM + wr * 64 + fr, col0 = u.pn * BM + wc * 32 + 8 * fq;
        f32x4 rs[2][2];
#pragma unroll
        for (int bj = 0; bj < 2; ++bj)
#pragma unroll
            for (int n = 0; n < 2; ++n) { const f32x4 q = *(const f32x4*)(rowss + col0 + bj * HALF + 4 * n);
#pragma unroll
                for (int e = 0; e < 4; ++e) rs[bj][n][e] = __builtin_amdgcn_rsqf(q[e] * (1.0f / D) + EPS); }
        const float* cb = cvec + (size_t)(u.pn >> 4) * D;
        float crv[2][4];
#pragma unroll
        for (int ai = 0; ai < 2; ++ai)
#pragma unroll
            for (int m = 0; m < 4; ++m) crv[ai][m] = cb[row0 + ai * HALF + m * 16];
#pragma unroll
        for (int ai = 0; ai < 2; ++ai)
#pragma unroll
            for (int m = 0; m < 4; ++m) { const int r = row0 + ai * HALF + m * 16; const int hh = r >> 6, d = r & 63; const float cr = crv[ai][m];
#pragma unroll
                for (int bj = 0; bj < 2; ++bj) { const int col = col0 + bj * HALF; const int b = col >> 12, sq = col & 4095;
                    bf16_t* p = O + ((size_t)((b * NHEAD + hh) * 128 + (sq >> 5)) * 4 + (d >> 5) * 2 + ((sq >> 4) & 1)) * 512 + (((sq >> 3) & 1) * 32 + (d & 31)) * 8;
                    const f32x4 v0 = acc[ai][bj][m][0] * rs[bj][0] + cr, v1 = acc[ai][bj][m][1] * rs[bj][1] + cr;
                    u32x4 w; w.x = cvt_pk_bf16(v0[0], v0[1]); w.y = cvt_pk_bf16(v0[2], v0[3]); w.z = cvt_pk_bf16(v1[0], v1[1]); w.w = cvt_pk_bf16(v1[2], v1[3]);
                    *(u32x4*)p = w; } }
    }
};
template <bool FUSE, bool RES_BF16, bool OUT_F32> struct EpiRes {
    static constexpr bool PERM = true;
    const void* res; float* out; const float* gate_l;
    bf16_t* Hn; const float* gs_l; float* rowss;
    const float* rgs_l;
    __device__ __forceinline__ void operator()(const f32x4 (&acc)[2][2][4][2], const Unit& u, int wr, int wc, int fr, int fq) const {
        const int row0 = u.pm * BM + wr * 64 + fr, col0 = u.pn * BM + wc * 32 + 8 * fq;
        const float* gate = gate_l + (size_t)(u.pm >> 4) * NMOD + col0;
        f32x4 gv[2][2], gs[2][2], rg[2][2];
#pragma unroll
        for (int bj = 0; bj < 2; ++bj)
#pragma unroll
            for (int n = 0; n < 2; ++n) { gv[bj][n] = *(const f32x4*)(gate + bj * HALF + 4 * n);
                if constexpr (FUSE) gs[bj][n] = *(const f32x4*)(gs_l + (size_t)(u.pm >> 4) * D + col0 + bj * HALF + 4 * n);
                if constexpr (RES_BF16) rg[bj][n] = *(const f32x4*)(rgs_l + (size_t)(u.pm >> 4) * D + col0 + bj * HALF + 4 * n); }
#pragma unroll
        for (int ai = 0; ai < 2; ++ai) {
          constexpr int MH = 2;
#pragma unroll
          for (int m0 = 0; m0 < 4; m0 += MH) {
            f32x4 rr[MH][2][2]; u32x4 rb[MH][2];
#pragma unroll
            for (int mm = 0; mm < MH; ++mm) { const size_t off = (size_t)(row0 + ai * HALF + (m0 + mm) * 16) * D + col0;
#pragma unroll
                for (int bj = 0; bj < 2; ++bj) {
                    if constexpr (RES_BF16) rb[mm][bj] = *(const u32x4*)((const bf16_t*)res + off + bj * HALF);
                    else { rr[mm][bj][0] = *(const f32x4*)((const float*)res + off + bj * HALF); rr[mm][bj][1] = *(const f32x4*)((const float*)res + off + bj * HALF + 4); } } }
#pragma unroll
            for (int mm = 0; mm < MH; ++mm) { const int m = m0 + mm; const int row = row0 + ai * HALF + m * 16; const size_t off = (size_t)row * D + col0;
                float ss = 0.f;
#pragma unroll
                for (int bj = 0; bj < 2; ++bj) {
                    f32x4 r[2], o[2];
                    if constexpr (RES_BF16) { const u32x4 q = rb[mm][bj];
                        r[0] = (f32x4){bflo(q.x), bfhi(q.x), bflo(q.y), bfhi(q.y)} * rg[bj][0]; r[1] = (f32x4){bflo(q.z), bfhi(q.z), bflo(q.w), bfhi(q.w)} * rg[bj][1]; }
                    else { r[0] = rr[mm][bj][0]; r[1] = rr[mm][bj][1]; }
#pragma unroll
                    for (int n = 0; n < 2; ++n) o[n] = r[n] + gv[bj][n] * acc[ai][bj][m][n];
                    if constexpr (OUT_F32) { __builtin_nontemporal_store(o[0], (f32x4*)(out + off + bj * HALF)); __builtin_nontemporal_store(o[1], (f32x4*)(out + off + bj * HALF + 4)); }
                    if constexpr (FUSE) {
                        ss += (o[0][0] * o[0][0] + o[0][1] * o[0][1]) + (o[0][2] * o[0][2] + o[0][3] * o[0][3]) + (o[1][0] * o[1][0] + o[1][1] * o[1][1]) + (o[1][2] * o[1][2] + o[1][3] * o[1][3]);
                        const f32x4 y0 = o[0] * gs[bj][0], y1 = o[1] * gs[bj][1];
                        u32x4 w; w.x = cvt_pk_bf16(y0[0], y0[1]); w.y = cvt_pk_bf16(y0[2], y0[3]); w.z = cvt_pk_bf16(y1[0], y1[1]); w.w = cvt_pk_bf16(y1[2], y1[3]);
                        *(u32x4*)(Hn + off + bj * HALF) = w; } }
                if constexpr (FUSE) { ss += __shfl_xor(ss, 16); ss += __shfl_xor(ss, 32); if (fq == 0) atomicAdd(rowss + row, ss); } }
          }
        }
    }
};
__device__ __forceinline__ float silu_f(float g) { return g * __builtin_amdgcn_rcpf(1.0f + __expf(-g)); }
struct EpiSwiGLU {
    static constexpr bool PERM = true;
    bf16_t* O; const float* rowss; const float* cvec;
    __device__ __forceinline__ void operator()(const f32x4 (&acc)[2][2][4][2], const Unit& u, int wr, int wc, int fr, int fq) const {
        const int row0 = u.pm * BM + wr * 64 + fr, col0 = u.pn * HALF + wc * 32 + 8 * fq;
        const float* cp = cvec + (size_t)(u.pm >> 4) * NGU + u.pn * BM + wc * 32 + 8 * fq;
        const f32x4 cg0 = *(const f32x4*)cp, cg1 = *(const f32x4*)(cp + 4), cu0 = *(const f32x4*)(cp + HALF), cu1 = *(const f32x4*)(cp + HALF + 4);
        float rsv[2][4];
#pragma unroll
        for (int ai = 0; ai < 2; ++ai)
#pragma unroll
            for (int m = 0; m < 4; ++m) rsv[ai][m] = rowss[row0 + ai * HALF + m * 16];
#pragma unroll
        for (int ai = 0; ai < 2; ++ai)
#pragma unroll
            for (int m = 0; m < 4; ++m) { const int row = row0 + ai * HALF + m * 16; bf16_t* rowp = O + (size_t)row * FF + col0;
                const float rstd = __builtin_amdgcn_rsqf(rsv[ai][m] * (1.0f / D) + EPS);
                const f32x4 g0 = acc[ai][0][m][0] * rstd + cg0, g1 = acc[ai][0][m][1] * rstd + cg1, u0 = acc[ai][1][m][0] * rstd + cu0, u1 = acc[ai][1][m][1] * rstd + cu1;
                u32x4 w; w.x = cvt_pk_bf16(silu_f(g0[0]) * u0[0], silu_f(g0[1]) * u0[1]); w.y = cvt_pk_bf16(silu_f(g0[2]) * u0[2], silu_f(g0[3]) * u0[3]);
                w.z = cvt_pk_bf16(silu_f(g1[0]) * u1[0], silu_f(g1[1]) * u1[1]); w.w = cvt_pk_bf16(silu_f(g1[2]) * u1[2], silu_f(g1[3]) * u1[3]);
                *(u32x4*)rowp = w; }
    }
};
struct EpiQK {
    static constexpr bool PERM = true;
    bf16_t* Qb; bf16_t* Kb; const float* qg; const float* kg; const float* rowss; const float* cvec;
    __device__ __forceinline__ void operator()(const f32x4 (&acc)[2][2][4][2], const Unit& u, int wr, int wc, int fr, int fq) const {
        const bool isq = u.pn < 4; const int hh = (u.pn & 3) * 4 + wc;
        const float* gp = (isq ? qg : kg) + 8 * fq; bf16_t* base = isq ? Qb : Kb;
        const float sc = isq ? 0.125f * 1.4426950408889634f : 1.0f;
        f32x4 gv[2][2];
#pragma unroll
        for (int bj = 0; bj < 2; ++bj)
#pragma unroll
            for (int n = 0; n < 2; ++n) gv[bj][n] = *(const f32x4*)(gp + 32 * bj + 4 * n) * sc;
        const int row0 = u.pm * BM + wr * 64 + fr;
        f32x4 cv[2][2];
        { const float* cp = cvec + (size_t)(u.pm >> 4) * NQK + u.pn * BM + wc * 32 + 8 * fq;
#pragma unroll
          for (int bj = 0; bj < 2; ++bj)
#pragma unroll
              for (int n = 0; n < 2; ++n) cv[bj][n] = *(const f32x4*)(cp + bj * HALF + 4 * n); }
        float rsv[2][4];
#pragma unroll
        for (int ai = 0; ai < 2; ++ai)
#pragma unroll
            for (int m = 0; m < 4; ++m) rsv[ai][m] = rowss[row0 + ai * HALF + m * 16];
#pragma unroll
        for (int ai = 0; ai < 2; ++ai)
#pragma unroll
            for (int m = 0; m < 4; ++m) { const int row = row0 + ai * HALF + m * 16; const int b = row >> 12, s = row & 4095;
                const float rs0 = __builtin_amdgcn_rsqf(rsv[ai][m] * (1.0f / D) + EPS);
                f32x4 xv[2][2];
                float ss = 0.f;
#pragma unroll
                for (int bj = 0; bj < 2; ++bj)
#pragma unroll
                    for (int n = 0; n < 2; ++n) { const f32x4 x = acc[ai][bj][m][n] * rs0 + cv[bj][n]; xv[bj][n] = x; ss += (x[0] * x[0] + x[1] * x[1]) + (x[2] * x[2] + x[3] * x[3]); }
                ss += __shfl_xor(ss, 16); ss += __shfl_xor(ss, 32);
                const float rstd = __builtin_amdgcn_rsqf(ss * (1.0f / 64.0f) + EPS);
                const int lr = s & 31; const int lrow = isq ? lr : ((lr & 19) | ((lr & 4) << 1) | ((lr & 8) >> 1));
                bf16_t* rowp = base + ((size_t)((b * NHEAD + hh) * 128 + (s >> 5)) * 4 + (fq >> 1)) * 512 + ((fq & 1) * 32 + lrow) * 8;
#pragma unroll
                for (int bj = 0; bj < 2; ++bj) { const f32x4 v0 = xv[bj][0] * gv[bj][0] * rstd, v1 = xv[bj][1] * gv[bj][1] * rstd;
                    u32x4 w; w.x = cvt_pk_bf16(v0[0], v0[1]); w.y = cvt_pk_bf16(v0[2], v0[3]); w.z = cvt_pk_bf16(v1[0], v1[1]); w.w = cvt_pk_bf16(v1[2], v1[3]);
                    *(u32x4*)(rowp + (2 * bj) * 512) = w; } }
    }
};
}

struct Args { const float* in[30]; float* out; unsigned char* ws; int ph_lo, ph_hi, coop, pad; };

__device__ __forceinline__ void transpose_item(const float* W, int K, int N, bf16_t* WT, int k0, int n0, int rbase, float* scr, int lane) {
    float tv[32];
#pragma unroll
    for (int i = 0; i < 32; ++i) tv[i] = __builtin_nontemporal_load(W + (size_t)(k0 + 2 * i + (lane >> 5)) * N + n0 + (lane & 31));
#pragma unroll
    for (int i = 0; i < 32; ++i) scr[(2 * i + (lane >> 5)) * 33 + (lane & 31)] = tv[i];
    __builtin_amdgcn_s_waitcnt(0xc07f); asm volatile("" ::: "memory");
    const int c = lane & 7;
#pragma unroll
    for (int j = 0; j < 4; ++j) { const int n = (lane >> 3) + 8 * j; const float* s = scr + (8 * c) * 33 + n;
        u32x4 o; o.x = cvt_pk_bf16(s[0 * 33], s[1 * 33]); o.y = cvt_pk_bf16(s[2 * 33], s[3 * 33]); o.z = cvt_pk_bf16(s[4 * 33], s[5 * 33]); o.w = cvt_pk_bf16(s[6 * 33], s[7 * 33]);
        *(u32x4*)(WT + (size_t)(rbase + n) * K + k0 + 8 * c) = o; }
    __builtin_amdgcn_s_waitcnt(0xc07f); asm volatile("" ::: "memory");
}
__device__ __forceinline__ void p0_prologue(const Args& a, unsigned char* lds) {
    const int tid = threadIdx.x, lane = tid & 63, w = tid >> 6;
    float* mod = (float*)(a.ws + WS_MOD);
    float* sc = (float*)lds; float* part = (float*)(lds + 32768);
    if ((int)blockIdx.x < 192) {
        const float* c = a.in[1];
        for (int e = tid; e < BATCH * D; e += 512) { const float v = c[e]; sc[e] = v / (1.0f + expf(-v)); }
        __syncthreads();
        for (int unit = blockIdx.x; unit < 192; unit += gridDim.x) {
            const int l = unit / 96, j = (unit % 96) * 64 + lane;
            const float* W = l == 0 ? a.in[2] : a.in[19]; const float* bias = l == 0 ? a.in[3] : a.in[20];
            float acc[8];
#pragma unroll
            for (int b = 0; b < 8; ++b) acc[b] = 0.f;
#pragma unroll 16
            for (int kk = 0; kk < 128; ++kk) { const int k = w * 128 + kk; const float wv = __builtin_nontemporal_load(W + (size_t)k * NMOD + j);
#pragma unroll
                for (int b = 0; b < 8; ++b) acc[b] += sc[b * D + k] * wv; }
#pragma unroll
            for (int b = 0; b < 8; ++b) part[(w * 8 + b) * 64 + lane] = acc[b];
            __syncthreads();
            { float s = 0.f;
#pragma unroll
              for (int ww = 0; ww < 8; ++ww) s += part[(ww * 8 + w) * 64 + lane];
              mod[(size_t)(l * 8 + w) * NMOD + j] = s + bias[j]; }
            __syncthreads();
        }
    }
    __syncthreads();
    float* scr = (float*)(lds + w * 16384);
    const int gw = blockIdx.x * 8 + w, NGW = gridDim.x * 8;
    constexpr int I_IN = 16 * (NIN / 32), I_O = 16 * 32, I_G = 16 * (FF / 32), I_D = (FF / 64) * 32, I_QKV = 16 * 96;
    constexpr int NITEMS = I_IN + 2 * I_O + 4 * I_G + 2 * I_D + I_QKV;
    static_assert(NITEMS == 12288, "item split below assumes 12288 items");
    const bool bal = (gridDim.x == 256);
    const int nmine = !bal ? 0 : ((int)blockIdx.x < 192 ? 5 : 9);
    const int first = !bal ? gw : ((int)blockIdx.x < 192 ? gw : 7680 + (gw - 1536)), stride = !bal ? NGW : ((int)blockIdx.x < 192 ? 1536 : 512);
    for (int it = first, cntI = 0; bal ? (cntI < nmine) : (it < NITEMS); it += stride, ++cntI) {
        int r = it;
        if (r < I_IN) { const int nb = NIN / 32; transpose_item(a.in[5], D, NIN, (bf16_t*)(a.ws + WS_WIN), 64 * (r / nb), 32 * (r % nb), 32 * (r % nb), scr, lane); continue; } r -= I_IN;
        if (r < I_O) { transpose_item(a.in[14], D, D, (bf16_t*)(a.ws + WS_WO0), 64 * (r / 32), 32 * (r % 32), 32 * (r % 32), scr, lane); continue; } r -= I_O;
        if (r < I_O) { transpose_item(a.in[25], D, D, (bf16_t*)(a.ws + WS_WO1), 64 * (r / 32), 32 * (r % 32), 32 * (r % 32), scr, lane); continue; } r -= I_O;
        if (r < 4 * I_G) { const int which = r / I_G; r -= which * I_G;
            const int nb = FF / 32, n0 = 32 * (r % nb); const int rb = (n0 >> 7) * 256 + (n0 & 127) + ((which & 1) ? 128 : 0);
            const float* src = which == 0 ? a.in[16] : which == 1 ? a.in[17] : which == 2 ? a.in[27] : a.in[28];
            transpose_item(src, D, FF, (bf16_t*)(a.ws + (which < 2 ? WS_WGU0 : WS_WGU1)), 64 * (r / nb), n0, rb, scr, lane); continue; } r -= 4 * I_G;
        if (r < 2 * I_D) { const int which = r / I_D; r -= which * I_D;
            transpose_item(which == 0 ? a.in[18] : a.in[29], FF, D, (bf16_t*)(a.ws + (which == 0 ? WS_WD0 : WS_WD1)), 64 * (r / 32), 32 * (r % 32), 32 * (r % 32), scr, lane); continue; } r -= 2 * I_D;
        { const int n0 = 32 * (r % 96), k0 = 64 * (r / 96);
          if (n0 < NQK) { const int which = n0 >> 10, hh = (n0 & 1023) >> 6, dh = (n0 & 63) >> 5; const int rb = (which * 4 + (hh >> 2)) * 256 + 128 * dh + 32 * (hh & 3);
              transpose_item(a.in[22], D, 3 * D, (bf16_t*)(a.ws + WS_WQK), k0, n0, rb, scr, lane); }
          else transpose_item(a.in[22], D, 3 * D, (bf16_t*)(a.ws + WS_WV), k0, n0, n0 - NQK, scr, lane); }
    }
}

__device__ __forceinline__ void norm_phase(const float* src, const float* gain, const float* shift_l, const float* scale_l, bf16_t* H) {
    const int lane = threadIdx.x & 63, w = threadIdx.x >> 6;
    const int gw = blockIdx.x * 8 + w, NGW = gridDim.x * 8;
    f32x4 g[4];
#pragma unroll
    for (int j = 0; j < 4; ++j) g[j] = *((const f32x4*)gain + lane + 64 * j);
    for (int m0 = gw * 2; m0 < M; m0 += NGW * 2) {
        f32x4 v[2][4]; float s[2];
#pragma unroll
        for (int r = 0; r < 2; ++r) { const f32x4* xr = (const f32x4*)(src + (size_t)(m0 + r) * D) + lane;
#pragma unroll
            for (int j = 0; j < 4; ++j) v[r][j] = __builtin_nontemporal_load(xr + 64 * j); }
#pragma unroll
        for (int r = 0; r < 2; ++r) { s[r] = 0.f;
#pragma unroll
            for (int j = 0; j < 4; ++j) s[r] += (v[r][j].x * v[r][j].x + v[r][j].y * v[r][j].y) + (v[r][j].z * v[r][j].z + v[r][j].w * v[r][j].w); }
        const int b = m0 >> 12;
        const f32x4* shp = (const f32x4*)(shift_l + (size_t)b * NMOD) + lane; const f32x4* scp = (const f32x4*)(scale_l + (size_t)b * NMOD) + lane;
#pragma unroll
        for (int r = 0; r < 2; ++r) { const float rstd = 1.0f / sqrtf(wave_sum(s[r]) * (1.0f / D) + EPS);
            u32x2* o8 = (u32x2*)(H + (size_t)(m0 + r) * D) + lane;
#pragma unroll
            for (int j = 0; j < 4; ++j) { const f32x4 sh = shp[64 * j], sc = scp[64 * j]; const f32x4 y = v[r][j] * rstd * g[j] * (sc + 1.0f) + sh;
                u32x2 o; o.x = cvt_pk_bf16(y.x, y.y); o.y = cvt_pk_bf16(y.z, y.w); o8[64 * j] = o; } }
    }
}

__device__ __forceinline__ void p1_extras(const Args& a, unsigned char* lds) {
    const int tid = threadIdx.x, lane = tid & 63, w = tid >> 6;
    const float* mod = (const float*)(a.ws + WS_MOD);
    float* rowss = (float*)(a.ws + WS_ROWSS); float* gsv = (float*)(a.ws + WS_GSV); float* cvec = (float*)(a.ws + WS_CVEC);
    const int gt = blockIdx.x * 512 + tid, NT = gridDim.x * 512;
    for (int e = gt; e < 3 * M; e += NT) rowss[e] = 0.f;
    for (int e = gt; e < 3 * 8 * D; e += NT) { const int nrm = e >> 13, b = (e >> 10) & 7, col = e & 1023;
        const float g = (nrm == 0 ? a.in[15] : nrm == 1 ? a.in[21] : a.in[26])[col];
        const float sc = mod[(size_t)((nrm == 0 ? 0 : 8) + b) * NMOD + (nrm == 1 ? 1 : 4) * D + col];
        float gsc = g * (1.0f + sc); if (fabsf(gsc) < 1e-12f) gsc = gsc < 0.f ? -1e-12f : 1e-12f;
        gsv[e] = gsc; gsv[3 * 8 * D + e] = 1.0f / gsc; }
    float* shl = (float*)lds;
#pragma unroll
    for (int q = 0; q < 12; ++q) { const int e = (tid + 512 * q) * 4, st = e >> 13, b = (e >> 10) & 7, k = e & 1023;
        *(f32x4*)(shl + e) = *(const f32x4*)(mod + (size_t)((st == 0 ? 0 : 8) + b) * NMOD + (st == 1 ? 0 : 3) * D + k); }
    __syncthreads();
    const int gw = blockIdx.x * 8 + w, NGW = gridDim.x * 8;
    constexpr int NROWS = NGU + NQK + D + NGU;
    auto row_ptr = [&](int r) -> const bf16_t* {
        if (r < NGU) return (const bf16_t*)(a.ws + WS_WGU0) + (size_t)r * D;
        if (r < NGU + NQK) return (const bf16_t*)(a.ws + WS_WQK) + (size_t)(r - NGU) * D;
        if (r < NGU + NQK + D) return (const bf16_t*)(a.ws + WS_WV) + (size_t)(r - NGU - NQK) * D;
        return (const bf16_t*)(a.ws + WS_WGU1) + (size_t)(r - NGU - NQK - D) * D; };
    u32x4 na = (u32x4){0u, 0u, 0u, 0u}, nb = na;
    if (gw < NROWS) { const bf16_t* p = row_ptr(gw); na = *(const u32x4*)(p + 8 * lane); nb = *(const u32x4*)(p + 512 + 8 * lane); }
    for (int r = gw; r < NROWS; r += NGW) {
        const float* sh; float* dst; int nstride;
        if (r < NGU) { sh = shl; dst = cvec + CV_GU0 + r; nstride = NGU; }
        else if (r < NGU + NQK) { sh = shl + 8 * D; dst = cvec + CV_QK + (r - NGU); nstride = NQK; }
        else if (r < NGU + NQK + D) { sh = shl + 8 * D; dst = cvec + CV_V + (r - NGU - NQK); nstride = D; }
        else { sh = shl + 16 * D; dst = cvec + CV_GU1 + (r - NGU - NQK - D); nstride = NGU; }
        const u32x4 wa = na, wb = nb;
        if (r + NGW < NROWS) { const bf16_t* p = row_ptr(r + NGW); na = *(const u32x4*)(p + 8 * lane); nb = *(const u32x4*)(p + 512 + 8 * lane); }
        float wf[16];
#pragma unroll
        for (int q = 0; q < 4; ++q) { wf[2 * q] = bflo(wa[q]); wf[2 * q + 1] = bfhi(wa[q]); wf[8 + 2 * q] = bflo(wb[q]); wf[8 + 2 * q + 1] = bfhi(wb[q]); }
        float myv = 0.f;
#pragma unroll
        for (int b = 0; b < 8; ++b) { const float* sp = sh + b * D + 8 * lane;
            const f32x4 s0 = *(const f32x4*)sp, s1 = *(const f32x4*)(sp + 4), s2 = *(const f32x4*)(sp + 512), s3 = *(const f32x4*)(sp + 516);
            float p = wf[0] * s0[0] + wf[1] * s0[1] + wf[2] * s0[2] + wf[3] * s0[3] + wf[4] * s1[0] + wf[5] * s1[1] + wf[6] * s1[2] + wf[7] * s1[3]
                    + wf[8] * s2[0] + wf[9] * s2[1] + wf[10] * s2[2] + wf[11] * s2[3] + wf[12] * s3[0] + wf[13] * s3[1] + wf[14] * s3[2] + wf[15] * s3[3];
            p = wave_sum(p); if (lane == b) myv = p; }
        if (lane < 8) dst[(size_t)lane * nstride] = myv;
    }
    __syncthreads();
}

constexpr float LOG2E = 1.4426950408889634f;
__device__ __forceinline__ float fsigmoid(float x) { return __builtin_amdgcn_rcpf(1.0f + __builtin_amdgcn_exp2f(-LOG2E * x)); }
__device__ __forceinline__ float gelu_tanh(float x) { const float u2 = 1.5957691216057308f * (x + 0.044715f * x * x * x); return x * fsigmoid(u2); }
__device__ __forceinline__ void mixer_a_item(const Args& a, const int lane, const int it) {
    const bf16_t* U = (const bf16_t*)(a.ws + WS_BIG); bf16_t* Y = (bf16_t*)(a.ws + WS_Y);
    float cw[3][8];
#pragma unroll
    for (int k = 0; k < 3; ++k)
#pragma unroll
        for (int i = 0; i < 8; ++i) cw[k][i] = a.in[6][k * 512 + 8 * lane + i];
    const size_t row0 = (size_t)it * 8; const int t0 = (int)(row0 & 4095);
    float p2[8], p1[8];
#pragma unroll
    for (int i = 0; i < 8; ++i) { p2[i] = 0.f; p1[i] = 0.f; }
    if (t0 >= 2) {
        const u32x4 c2 = *(const u32x4*)(U + (row0 - 2) * NIN + 512 + 8 * lane), x2 = *(const u32x4*)(U + (row0 - 2) * NIN + 1024 + 8 * lane);
        const u32x4 c1 = *(const u32x4*)(U + (row0 - 1) * NIN + 512 + 8 * lane), x1 = *(const u32x4*)(U + (row0 - 1) * NIN + 1024 + 8 * lane);
#pragma unroll
        for (int q = 0; q < 4; ++q) { p2[2 * q] = bflo(c2[q]) * bflo(x2[q]); p2[2 * q + 1] = bfhi(c2[q]) * bfhi(x2[q]); p1[2 * q] = bflo(c1[q]) * bflo(x1[q]); p1[2 * q + 1] = bfhi(c1[q]) * bfhi(x1[q]); }
    }
#pragma unroll
    for (int tt = 0; tt < 8; ++tt) { const size_t row = row0 + tt;
        const u32x4 ab = *(const u32x4*)(U + row * NIN + 8 * lane), ac = *(const u32x4*)(U + row * NIN + 512 + 8 * lane), ax = *(const u32x4*)(U + row * NIN + 1024 + 8 * lane);
        float p[8], y[8];
#pragma unroll
        for (int q = 0; q < 4; ++q) { p[2 * q] = bflo(ac[q]) * bflo(ax[q]); p[2 * q + 1] = bfhi(ac[q]) * bfhi(ax[q]); }
#pragma unroll
        for (int q = 0; q < 4; ++q) { y[2 * q] = bflo(ab[q]) * (cw[0][2 * q] * p2[2 * q] + cw[1][2 * q] * p1[2 * q] + cw[2][2 * q] * p[2 * q]);
            y[2 * q + 1] = bfhi(ab[q]) * (cw[0][2 * q + 1] * p2[2 * q + 1] + cw[1][2 * q + 1] * p1[2 * q + 1] + cw[2][2 * q + 1] * p[2 * q + 1]); }
        u32x4 o; o.x = cvt_pk_bf16(y[0], y[1]); o.y = cvt_pk_bf16(y[2], y[3]); o.z = cvt_pk_bf16(y[4], y[5]); o.w = cvt_pk_bf16(y[6], y[7]);
        *(u32x4*)(Y + row * D + 8 * lane) = o;
#pragma unroll
        for (int i = 0; i < 8; ++i) { p2[i] = p1[i]; p1[i] = p[i]; } }
}

__device__ __forceinline__ void scan_phase(const Args& a, unsigned char* lds) {
    const int tid = threadIdx.x, lane = tid & 63, w = tid >> 6;
    const bf16_t* U = (const bf16_t*)(a.ws + WS_BIG); bf16_t* Y = (bf16_t*)(a.ws + WS_Y);
    unsigned long long* agg = (unsigned long long*)(a.ws + WS_XR);
    unsigned* cnt = (unsigned*)(a.ws + WS_BAR) + 3456  ;
    bf16_t* Wl = (bf16_t*)lds;
    float* cw = (float*)(lds + 18432);
    unsigned char* wb = lds + 20480 + w * 16640;
    bf16_t* raw = (bf16_t*)wb;
    float* xr = (float*)(wb + 2816);
    bf16_t* hlb = (bf16_t*)(wb + 7168);
    bf16_t* acb = (bf16_t*)(wb + 11776);
    float* cy = (float*)(wb + 16384);
    const int r16 = lane & 15, kq = lane >> 4;
    const int vb = blockIdx.x, head = (vb >> 4) & 7;
    __syncthreads();
    { float tv[16];
#pragma unroll
      for (int q = 0; q < 16; ++q) { const int e = tid + 512 * q; tv[q] = (e < 4096 ? a.in[9] : a.in[11])[(size_t)head * 4096 + (e & 4095)]; }
#pragma unroll
      for (int q = 0; q < 16; ++q) { const int e = tid + 512 * q, gte = e >> 12, i = (e >> 6) & 63, jn = e & 63;
          Wl[(gte * 64 + jn) * 72 + i] = (bf16_t)(cvt_pk_bf16(tv[q], 0.f) & 0xffffu); }
      if (tid < 320) cw[tid] = tid < 256 ? a.in[7][(tid >> 6) * 512 + head * 64 + (tid & 63)] : a.in[8][head * 64 + (tid & 63)]; }
    float gba[4], gbx[4], gsp[4];
#pragma unroll
    for (int nt = 0; nt < 4; ++nt) { const int c2 = head * 64 + nt * 16 + r16; gba[nt] = a.in[10][c2] * (-LOG2E); gbx[nt] = a.in[12][c2] * (-LOG2E);
        const float lam = a.in[13][c2]; gsp[nt] = (-8.0f * LOG2E) * (fmaxf(-lam, 0.f) + log1pf(expf(-fabsf(lam)))); }
    __syncthreads();
    u32x4 pre[3];
    for (int rnd = 0; rnd < 4; ++rnd) {
        const int pair = (vb >> 4) + 16 * rnd, b = pair >> 3, seg = (vb & 15) * 8 + w, t0 = seg * 32;
        float Arun[4], Hrun[4];
#pragma unroll
        for (int nt = 0; nt < 4; ++nt) { Arun[nt] = 1.f; Hrun[nt] = 0.f; }
#define SCAN_FETCHB(BB, TC) do { _Pragma("unroll") for (int i = 0; i < 3; ++i) { const int e = lane + 64 * i, rr = e >> 3, ck = e & 7, t = (TC) - 3 + rr; pre[i] = (u32x4){0u, 0u, 0u, 0u}; \
            if (e < 19 * 8 && t >= 0) pre[i] = *(const u32x4*)(U + (size_t)((BB) * SEQ + t) * NIN + 2048 + head * 64 + ck * 8); } } while (0)
#define SCAN_FETCH(TC) SCAN_FETCHB(b, TC)
        if (rnd == 0) SCAN_FETCH(t0);
#pragma unroll
        for (int c = 0; c < 2; ++c) {
            const int tc = t0 + 16 * c;
#pragma unroll
            for (int i = 0; i < 3; ++i) { const int e = lane + 64 * i; if (e < 19 * 8) *(u32x4*)(raw + (e >> 3) * 72 + (e & 7) * 8) = pre[i]; }
            if (c < 1) SCAN_FETCH(tc + 16);
            bf16x8 af[2];
#pragma unroll
            for (int ks = 0; ks < 2; ++ks) { const int c0 = 32 * ks + 8 * kq;
                f32x4 v0 = *(const f32x4*)(cw + 256 + c0), v1 = *(const f32x4*)(cw + 256 + c0 + 4);
#pragma unroll
                for (int tap = 0; tap < 4; ++tap) { const u32x4 xq = *(const u32x4*)(raw + (r16 + tap) * 72 + c0);
                    const f32x4 w0 = *(const f32x4*)(cw + tap * 64 + c0), w1 = *(const f32x4*)(cw + tap * 64 + c0 + 4);
                    v0 = v0 + w0 * (f32x4){bflo(xq.x), bfhi(xq.x), bflo(xq.y), bfhi(xq.y)}; v1 = v1 + w1 * (f32x4){bflo(xq.z), bfhi(xq.z), bflo(xq.w), bfhi(xq.w)}; }
                *(f32x4*)(xr + r16 * 68 + c0) = v0; *(f32x4*)(xr + r16 * 68 + c0 + 4) = v1;
                u32x4 pk; pk.x = cvt_pk_bf16(v0[0], v0[1]); pk.y = cvt_pk_bf16(v0[2], v0[3]); pk.z = cvt_pk_bf16(v1[0], v1[1]); pk.w = cvt_pk_bf16(v1[2], v1[3]);
                af[ks] = __builtin_bit_cast(bf16x8, pk); }
#pragma unroll
            for (int nt = 0; nt < 4; ++nt) {
                f32x4 ca = (f32x4){0.f, 0.f, 0.f, 0.f}, cx = (f32x4){0.f, 0.f, 0.f, 0.f};
#pragma unroll
                for (int ks = 0; ks < 2; ++ks) {
                    const bf16x8 bA = *(const bf16x8*)(Wl + (nt * 16 + r16) * 72 + ks * 32 + kq * 8);
                    const bf16x8 bX = *(const bf16x8*)(Wl + (64 + nt * 16 + r16) * 72 + ks * 32 + kq * 8);
                    ca = __builtin_amdgcn_mfma_f32_16x16x32_bf16(af[ks], bA, ca, 0, 0, 0);
                    cx = __builtin_amdgcn_mfma_f32_16x16x32_bf16(af[ks], bX, cx, 0, 0, 0); }
                const int ch = nt * 16 + r16;
                float As[4], Hs[4], A = 1.f, H = 0.f;
#pragma unroll
                for (int jj = 0; jj < 4; ++jj) { const int tok = 4 * kq + jj;
                    const float r = __builtin_amdgcn_rcpf(1.0f + __builtin_amdgcn_exp2f(ca[jj] * (-LOG2E) + gba[nt]));
                    const float ig = __builtin_amdgcn_rcpf(1.0f + __builtin_amdgcn_exp2f(cx[jj] * (-LOG2E) + gbx[nt]));
                    const float a1 = __builtin_amdgcn_exp2f(r * gsp[nt]); const float xv = xr[tok * 68 + ch];
                    const float om = fmaxf(__builtin_fmaf(-a1, a1, 1.0f), 0.0f);
                    const float b1 = __builtin_amdgcn_sqrtf(om) * (ig * xv);
                    H = a1 * H + b1; A *= a1; As[jj] = A; Hs[jj] = H; }
                const float A1 = __shfl_up(A, 16), H1 = __shfl_up(H, 16), A2 = __shfl_up(A, 32), H2 = __shfl_up(H, 32), A3 = __shfl_up(A, 48), H3 = __shfl_up(H, 48);
                float ea = 1.f, eh = 0.f;
                if (kq >= 3) { ea = A3; eh = H3; }
                if (kq >= 2) { eh = A2 * eh + H2; ea *= A2; }
                if (kq >= 1) { eh = A1 * eh + H1; ea *= A1; }
                const float WA = __shfl(A * ea, 48 + r16), WH = __shfl(A * eh + H, 48 + r16);
                const float pa = ea * Arun[nt], ph = ea * Hrun[nt] + eh;
#pragma unroll
                for (int jj = 0; jj < 4; ++jj) { const int ts = 16 * c + 4 * kq + jj;
                    acb[ts * 72 + ch] = (bf16_t)(cvt_pk_bf16(As[jj] * pa, 0.f) & 0xffffu);
                    hlb[ts * 72 + ch] = (bf16_t)(cvt_pk_bf16(As[jj] * ph + Hs[jj], 0.f) & 0xffffu); }
                Hrun[nt] = WA * Hrun[nt] + WH; Arun[nt] *= WA;
            }
        }
        float2* bagg = (float2*)(lds + 20480 + 8 * 16640);
        if (kq == 0) {
#pragma unroll
            for (int nt = 0; nt < 4; ++nt) { float2 v; v.x = Arun[nt]; v.y = Hrun[nt]; bagg[w * 64 + nt * 16 + r16] = v; }
        }
        const u32x4 g0 = *(const u32x4*)(U + (size_t)(b * SEQ + t0 + (lane >> 3)) * NIN + 1536 + head * 64 + (lane & 7) * 8);
        const u32x4 g1 = *(const u32x4*)(U + (size_t)(b * SEQ + t0 + 8 + (lane >> 3)) * NIN + 1536 + head * 64 + (lane & 7) * 8);
        const u32x4 g2 = *(const u32x4*)(U + (size_t)(b * SEQ + t0 + 16 + (lane >> 3)) * NIN + 1536 + head * 64 + (lane & 7) * 8);
        const u32x4 g3 = *(const u32x4*)(U + (size_t)(b * SEQ + t0 + 24 + (lane >> 3)) * NIN + 1536 + head * 64 + (lane & 7) * 8);
        __syncthreads();
        float PA = 1.f, PH = 0.f, BA = 1.f, BH = 0.f;
#pragma unroll
        for (int ww = 0; ww < 8; ++ww) { const float2 v = bagg[ww * 64 + lane]; if (ww == w) { PA = BA; PH = BH; } BH = v.x * BH + v.y; BA *= v.x; }
        __syncthreads();
        const int blk = vb & 15;
        if (w == 0) {
            const unsigned long long v = (unsigned long long)__builtin_bit_cast(unsigned, BA) | ((unsigned long long)__builtin_bit_cast(unsigned, BH) << 32);
            __hip_atomic_store(agg + ((size_t)pair * 16 + blk) * 64 + lane, v, __ATOMIC_RELAXED, __HIP_MEMORY_SCOPE_AGENT);
            asm volatile("s_waitcnt vmcnt(0)" ::: "memory");
            if (lane == 0) __hip_atomic_fetch_add(cnt + pair * 16, 1u, __ATOMIC_RELAXED, __HIP_MEMORY_SCOPE_AGENT);
        }
        if (rnd < 2) mixer_a_item(a, lane, (int)(blockIdx.x * 8 + w) + rnd * (int)(gridDim.x * 8));
        if (rnd < 3) SCAN_FETCHB(b + 2, t0);
        if (lane == 0) { unsigned sp = 0;
            while (__hip_atomic_load(cnt + pair * 16, __ATOMIC_RELAXED, __HIP_MEMORY_SCOPE_AGENT) < 16u) { __builtin_amdgcn_s_sleep(1); if (++sp > (1u << 22)) break; } }
        { float hcar = 0.f; const unsigned long long* ap = agg + (size_t)pair * 16 * 64 + lane;
          unsigned long long q[15];
#pragma unroll
          for (int k = 0; k < 15; ++k) q[k] = __hip_atomic_load(ap + (size_t)(k < blk ? k : 0) * 64, __ATOMIC_RELAXED, __HIP_MEMORY_SCOPE_AGENT);
#pragma unroll
          for (int k = 0; k < 15; ++k) if (k < blk) hcar = __builtin_bit_cast(float, (unsigned)(q[k] & 0xffffffffull)) * hcar + __builtin_bit_cast(float, (unsigned)(q[k] >> 32));
          cy[lane] = PA * hcar + PH; }
        { const int ck = lane & 7; const f32x4 c0 = *(const f32x4*)(cy + ck * 8), c1 = *(const f32x4*)(cy + ck * 8 + 4);
#pragma unroll
          for (int q = 0; q < 4; ++q) { const int tl = 8 * q + (lane >> 3); const u32x4 gt = q == 0 ? g0 : q == 1 ? g1 : q == 2 ? g2 : g3;
              const u32x4 av = *(const u32x4*)(acb + tl * 72 + ck * 8), hv = *(const u32x4*)(hlb + tl * 72 + ck * 8);
              float y[8];
              y[0] = gelu_tanh(bflo(gt.x)) * (bflo(av.x) * c0[0] + bflo(hv.x)); y[1] = gelu_tanh(bfhi(gt.x)) * (bfhi(av.x) * c0[1] + bfhi(hv.x));
              y[2] = gelu_tanh(bflo(gt.y)) * (bflo(av.y) * c0[2] + bflo(hv.y)); y[3] = gelu_tanh(bfhi(gt.y)) * (bfhi(av.y) * c0[3] + bfhi(hv.y));
              y[4] = gelu_tanh(bflo(gt.z)) * (bflo(av.z) * c1[0] + bflo(hv.z)); y[5] = gelu_tanh(bfhi(gt.z)) * (bfhi(av.z) * c1[1] + bfhi(hv.z));
              y[6] = gelu_tanh(bflo(gt.w)) * (bflo(av.w) * c1[2] + bflo(hv.w)); y[7] = gelu_tanh(bfhi(gt.w)) * (bfhi(av.w) * c1[3] + bfhi(hv.w));
              u32x4 o; o.x = cvt_pk_bf16(y[0], y[1]); o.y = cvt_pk_bf16(y[2], y[3]); o.z = cvt_pk_bf16(y[4], y[5]); o.w = cvt_pk_bf16(y[6], y[7]);
              *(u32x4*)(Y + (size_t)(b * SEQ + t0 + tl) * D + 512 + head * 64 + ck * 8) = o; } }
    }
#undef SCAN_FETCH
#undef SCAN_FETCHB
}

__device__ __forceinline__ f32x16 attn_qk(const bf16x8 (&Kc)[4], const bf16x8 (&Qf)[4]) {
    f32x16 S;
#pragma unroll
    for (int r = 0; r < 16; ++r) S[r] = 0.f;
#pragma unroll
    for (int ks = 0; ks < 4; ++ks) S = __builtin_amdgcn_mfma_f32_32x32x16_bf16(Kc[ks], Qf[ks], S, 0, 0, 0);
    return S;
}
__device__ __forceinline__ void attn_rest(const f32x16& S, const bf16x8 (&Vc)[2][2], f32x16 (&Oa)[2], float& R, const bool diag, const int l32, const int hf) {
    float kp[16], bt[16];
#pragma unroll
    for (int r = 0; r < 16; ++r) { const float E = __builtin_amdgcn_exp2f(S[r]); const float kk = __builtin_amdgcn_rcpf(1.0f + E); kp[r] = kk; bt[r] = E * kk; }
    if (diag) {
#pragma unroll
        for (int r = 0; r < 16; ++r) { const int ko = 16 * (r >> 3) + 8 * hf + (r & 7); if (ko >= l32) { kp[r] = 1.0f; bt[r] = 0.0f; } }
    }
    float sx[16], Pm[2], Qm[2];
#pragma unroll
    for (int m = 0; m < 2; ++m) { sx[8 * m + 7] = 1.0f;
#pragma unroll
        for (int r = 6; r >= 0; --r) sx[8 * m + r] = sx[8 * m + r + 1] * kp[8 * m + r + 1];
        Pm[m] = sx[8 * m] * kp[8 * m]; Qm[m] = __shfl_xor(Pm[m], 32); }
    const float T1 = R, T0 = R * (Pm[1] * Qm[1]); R = T0 * (Pm[0] * Qm[0]);
    const float base1 = hf == 0 ? T1 * Qm[1] : T1, base0 = hf == 0 ? T0 * Qm[0] : T0;
#pragma unroll
    for (int m = 0; m < 2; ++m) { const float base = m == 0 ? base0 : base1;
        float wv[8];
#pragma unroll
        for (int i = 0; i < 8; ++i) wv[i] = bt[8 * m + i] * (sx[8 * m + i] * base);
        u32x4 pk; pk.x = cvt_pk_bf16(wv[0], wv[1]); pk.y = cvt_pk_bf16(wv[2], wv[3]); pk.z = cvt_pk_bf16(wv[4], wv[5]); pk.w = cvt_pk_bf16(wv[6], wv[7]);
        const bf16x8 pb = __builtin_bit_cast(bf16x8, pk);
#pragma unroll
        for (int dt = 0; dt < 2; ++dt) Oa[dt] = __builtin_amdgcn_mfma_f32_32x32x16_bf16(Vc[dt][m], pb, Oa[dt], 0, 0, 0);
    }
}
__device__ __forceinline__ void attn_phase(const Args& a, unsigned char* lds) {
    const int tid = threadIdx.x, lane = tid & 63, w = __builtin_amdgcn_readfirstlane(tid >> 6), l32 = lane & 31, hf = lane >> 5;
    bf16_t* ot = (bf16_t*)(lds + w * 4608);
    __builtin_amdgcn_s_setreg(1 | (4 << 6) | (1 << 11), 0);
    if (w >= 4) __builtin_amdgcn_s_setprio(1);
    const bf16_t* Qb = (const bf16_t*)(a.ws + WS_Q); const bf16_t* Kb = (const bf16_t*)(a.ws + WS_K); const bf16_t* Vt = (const bf16_t*)(a.ws + WS_VT);
    bf16_t* O = (bf16_t*)(a.ws + WS_Y);
    const int vb = (gridDim.x % 8 == 0) ? (int)(blockIdx.x % 8) * (int)(gridDim.x / 8) + (int)(blockIdx.x / 8) : (int)blockIdx.x;
    const int gw = vb * 8 + w, NGW = gridDim.x * 8;
    for (int unit = gw; unit < 8192; unit += NGW) {
        const int bh = unit >> 6, qg = unit & 63, b = bh >> 4, hh = bh & 15;
        const int qw = qg * 64;
        const bf16_t* Qg = Qb + (size_t)bh * 128 * 2048 + lane * 8;
        const bf16_t* Kg = Kb + (size_t)bh * 128 * 2048 + lane * 8;
        const bf16_t* Vg = Vt + (size_t)bh * 128 * 2048 + lane * 8;
        bf16x8 Qf0[4], Qf1[4];
#pragma unroll
        for (int ks = 0; ks < 4; ++ks) { Qf0[ks] = *(const bf16x8*)(Qg + (size_t)(qw >> 5) * 2048 + ks * 512);
            Qf1[ks] = *(const bf16x8*)(Qg + (size_t)((qw >> 5) + 1) * 2048 + ks * 512); }
        f32x16 Oa0[2], Oa1[2];
#pragma unroll
        for (int r = 0; r < 16; ++r) { Oa0[0][r] = 0.f; Oa0[1][r] = 0.f; Oa1[0][r] = 0.f; Oa1[1][r] = 0.f; }
        float R0 = 1.0f, R1 = 1.0f;
        int kb = qw + 32;
        bf16x8 Ka[4], Va[2][2], Kz[4], Vz[2][2];
#define ATT_LDK(Kx, blk) do { _Pragma("unroll") for (int ks = 0; ks < 4; ++ks) Kx[ks] = *(const bf16x8*)(Kg + (size_t)(blk) * 2048 + ks * 512); } while (0)
#define ATT_LDV(Vx, blk) do { _Pragma("unroll") for (int dt = 0; dt < 2; ++dt) _Pragma("unroll") for (int m = 0; m < 2; ++m) Vx[dt][m] = *(const bf16x8*)(Vg + (size_t)(blk) * 2048 + (dt * 2 + m) * 512); } while (0)
#define ATT_ITER(Kx, Vx) { \
            const bool first = kb > qw;                         \
            const f32x16 S1 = attn_qk(Kx, Qf1); f32x16 S0; if (!first) S0 = attn_qk(Kx, Qf0); \
            if (kb >= 64) ATT_LDK(Kx, (kb >> 5) - 2); \
            attn_rest(S1, Vx, Oa1, R1, first, l32, hf);         \
            if (!first) attn_rest(S0, Vx, Oa0, R0, kb == qw, l32, hf); \
            if (kb == 0) break; \
            if (__builtin_amdgcn_ballot_w64(R0 != 0.0f || R1 != 0.0f) == 0ull) break; \
            if (kb >= 64) ATT_LDV(Vx, (kb >> 5) - 2); \
            kb -= 32; }
        ATT_LDK(Ka, kb >> 5); ATT_LDV(Va, kb >> 5); ATT_LDK(Kz, (kb >> 5) - 1); ATT_LDV(Vz, (kb >> 5) - 1);
        for (;;) { ATT_ITER(Ka, Va) ATT_ITER(Kz, Vz) }
#undef ATT_ITER
#undef ATT_LDK
#undef ATT_LDV
#pragma unroll
        for (int st = 0; st < 2; ++st) {
#pragma unroll
            for (int dt = 0; dt < 2; ++dt)
#pragma unroll
                for (int g = 0; g < 4; ++g) { const f32x16& oo = st == 0 ? Oa0[dt] : Oa1[dt];
                    u32x2 o; o.x = cvt_pk_bf16(oo[4 * g], oo[4 * g + 1]); o.y = cvt_pk_bf16(oo[4 * g + 2], oo[4 * g + 3]);
                    *(u32x2*)(ot + l32 * 72 + 32 * dt + 8 * g + 4 * hf) = o; }
#pragma unroll
            for (int i = 0; i < 4; ++i) { const int row = 8 * i + (lane >> 3), ck = lane & 7;
                const u32x4 v = *(const u32x4*)(ot + row * 72 + ck * 8);
                *(u32x4*)(O + (size_t)(b * SEQ + qw + 32 * st + row) * D + hh * HD + ck * 8) = v; }
        }
    }
    __builtin_amdgcn_s_setprio(0);
    __builtin_amdgcn_s_setreg(1 | (4 << 6) | (1 << 11), 3);
}

#define XB_TMO      128
#define XB_XCNT(j)  (256  + 64 * (j))
#define XB_XSUB(j)  (1280 + 64 * (j))
#define XB_XGEN(j)  (2304 + 64 * (j))
#define XB_TOP      3328
#define XB_TOPGEN   3392
#define XCD_BAR_WORDS 3456
#define XB_SPIN_CAP (1u << 18)
__device__ __forceinline__ unsigned xb_ld(unsigned* p)              { return __hip_atomic_load(p, __ATOMIC_RELAXED, __HIP_MEMORY_SCOPE_AGENT); }
__device__ __forceinline__ unsigned xb_add(unsigned* p, unsigned v) { return __hip_atomic_fetch_add(p, v, __ATOMIC_RELAXED, __HIP_MEMORY_SCOPE_AGENT); }
__device__ __forceinline__ unsigned xb_xcc_id() { return (unsigned)__builtin_amdgcn_s_getreg((3 << 11) | 20) & 0xFu; }
#define XB_SPIN(cond, bar) do { unsigned _sp = 0; while (cond) { __builtin_amdgcn_s_sleep(1); \
    if ((++_sp & 255u) == 0u) { if (xb_ld(&(bar)[XB_TMO])) break; if (_sp > XB_SPIN_CAP) { atomicAdd(&(bar)[XB_TMO], 1u); break; } } } } while (0)
struct XcdBarrier { unsigned* bar; unsigned x; volatile LAS unsigned* st; };
__device__ __forceinline__ XcdBarrier xcd_barrier_post(unsigned* bar, volatile LAS unsigned* st) {
    XcdBarrier b; b.bar = bar; b.x = xb_xcc_id(); b.st = st;
    if (threadIdx.x == 0) (void)xb_add(&bar[XB_XCNT(b.x)], 1u);
    return b;
}
__device__ __forceinline__ void xcd_barrier_complete(unsigned* bar, unsigned x, unsigned& nloc, unsigned& nx) {
    const unsigned G = gridDim.x * gridDim.y * gridDim.z;
    unsigned sum, cnt, mine, sp = 0u;
    for (;;) {
        sum = 0u; cnt = 0u; mine = 0u;
#pragma unroll
        for (unsigned j = 0; j < 16; ++j) { const unsigned c = xb_ld(&bar[XB_XCNT(j)]); sum += c; cnt += (c > 0u) ? 1u : 0u; mine = (j == x) ? c : mine; }
        if (sum == G) break;
        __builtin_amdgcn_s_sleep(1);
        if ((++sp & 255u) == 0u) { if (xb_ld(&bar[XB_TMO])) break; if (sp > XB_SPIN_CAP) { atomicAdd(&bar[XB_TMO], 1u); break; } }
    }
    nloc = mine > 0u ? mine : 1u; nx = cnt > 0u ? cnt : 1u;
}
__device__ __forceinline__ void xcd_barrier(const XcdBarrier& b) {
    asm volatile("s_waitcnt vmcnt(0)" ::: "memory");
    __syncthreads();
    if (threadIdx.x == 0) {
        unsigned* bar = b.bar;
        __builtin_amdgcn_s_waitcnt(0);
        unsigned nloc = b.st[0], nx = b.st[1];
        if (nloc == 0u) { xcd_barrier_complete(bar, b.x, nloc, nx); b.st[0] = nloc; b.st[1] = nx; }
        const unsigned old = xb_add(&bar[XB_XSUB(b.x)], 1u);
        const unsigned gen = old / nloc;
        if (old + 1u == (gen + 1u) * nloc) {
            __builtin_amdgcn_fence(__ATOMIC_RELEASE, "agent");
            asm volatile("s_waitcnt vmcnt(0)" ::: "memory");
            const unsigned og = xb_add(&bar[XB_TOP], 1u);
            const unsigned tg = og / nx;
            if (og + 1u == (tg + 1u) * nx) xb_add(&bar[XB_TOPGEN], 1u);
            else XB_SPIN(xb_ld(&bar[XB_TOPGEN]) == tg, bar);
            __builtin_amdgcn_fence(__ATOMIC_ACQUIRE, "agent");
            xb_add(&bar[XB_XGEN(b.x)], 1u);
            asm volatile("s_waitcnt vmcnt(0)" ::: "memory");
        } else {
            XB_SPIN(xb_ld(&bar[XB_XGEN(b.x)]) == gen, bar);
            __builtin_amdgcn_fence(__ATOMIC_ACQUIRE, "agent");
            asm volatile("s_waitcnt vmcnt(0)" ::: "memory");
        }
    }
    __syncthreads();
}

template <int PH, bool DUMMY = false> __device__ __forceinline__ void run_phase(const Args& a, unsigned char* lds) {
    float* mod = (float*)(a.ws + WS_MOD);
    bf16_t* H = (bf16_t*)(a.ws + WS_H); bf16_t* Y = (bf16_t*)(a.ws + WS_Y); bf16_t* BIG = (bf16_t*)(a.ws + WS_BIG);
    float* rowss = (float*)(a.ws + WS_ROWSS); const float* gsv = (const float*)(a.ws + WS_GSV); const float* rgsv = gsv + 3 * 8 * D; const float* cvec = (const float*)(a.ws + WS_CVEC);
    PG8_LAS unsigned char* glds = (PG8_LAS unsigned char*)lds;
    constexpr int l = PH >= 9 ? 1 : 0;
    if constexpr (PH == 0) {
        p0_prologue(a, lds);
    } else if constexpr (PH == 1) {
        norm_phase(a.in[0], a.in[4], mod, mod + D, H);
        p1_extras(a, lds);
    } else if constexpr (PH == 2) {
        pg8::Gemm g{H, (const bf16_t*)(a.ws + WS_WIN), M, NIN, D}; pg8::EpiBf16 E{BIG, NIN};
        pg8::StaticOrder S; S.init(M, NIN, gridDim.x, blockIdx.x);
        pg8::gemm_phase<pg8::EpiBf16, pg8::StaticOrder, true, true>(glds, g, S, E);
    } else if constexpr (PH == 10) {
        { pg8::Gemm g{H, (const bf16_t*)(a.ws + WS_WQK), M, NQK, D}; pg8::StaticOrder S; S.init(M, NQK, gridDim.x, blockIdx.x);
          pg8::EpiQK E{(bf16_t*)(a.ws + WS_Q), (bf16_t*)(a.ws + WS_K), a.in[23], a.in[24], rowss + M, cvec + CV_QK};
          pg8::gemm_phase<pg8::EpiQK, pg8::StaticOrder, true, true>(glds, g, S, E); }
        { pg8::Gemm g{(const bf16_t*)(a.ws + WS_WV), H, D, M, D}; pg8::EpiVt E{(bf16_t*)(a.ws + WS_VT), rowss + M, cvec + CV_V};
          pg8::StaticOrder S; S.init(D, M, gridDim.x, blockIdx.x);
          pg8::gemm_phase<pg8::EpiVt, pg8::StaticOrder, true, true>(glds, g, S, E); }
    } else if constexpr (PH == 3) {
        scan_phase(a, lds);
    } else if constexpr (PH == 5 || PH == 12) {
        constexpr int nrm = PH == 5 ? 0 : 2;
        pg8::Gemm g{Y, (const bf16_t*)(a.ws + (PH == 5 ? WS_WO0 : WS_WO1)), M, D, D};
        typedef pg8::EpiRes<true, PH != 5, false> EpiT;
        bf16_t* dmy = (bf16_t*)(a.ws + 442 * MiB); float* dmr = (float*)(a.ws + 506 * MiB);
        EpiT E{PH == 5 ? (const void*)a.in[0] : (const void*)H, nullptr, mod + (size_t)l * 8 * NMOD + 2 * D, DUMMY ? dmy : H, gsv + nrm * 8 * D, DUMMY ? dmr : rowss + (size_t)nrm * M, rgsv + 1 * 8 * D};
        pg8::StaticOrder S; S.init(M, D, gridDim.x, blockIdx.x);
        pg8::gemm_phase<EpiT, pg8::StaticOrder, true, true>(glds, g, S, E);
    } else if constexpr (PH == 8) {
        pg8::Gemm g{BIG, (const bf16_t*)(a.ws + WS_WD0), M, D, FF};
        typedef pg8::EpiRes<true, true, false> EpiT;
        bf16_t* dmy = (bf16_t*)(a.ws + 442 * MiB); float* dmr = (float*)(a.ws + 506 * MiB);
        EpiT E{H, nullptr, mod + 5 * D, DUMMY ? dmy : H, gsv + 1 * 8 * D, DUMMY ? dmr : rowss + (size_t)1 * M, rgsv + 0 * 8 * D};
        pg8::StaticOrder S; S.init(M, D, gridDim.x, blockIdx.x);
        pg8::gemm_phase<EpiT, pg8::StaticOrder, true, true>(glds, g, S, E);
    } else if constexpr (PH == 15) {
        pg8::Gemm g{BIG, (const bf16_t*)(a.ws + WS_WD1), M, D, FF};
        typedef pg8::EpiRes<false, true, true> EpiT;
        EpiT E{H, a.out, mod + (size_t)8 * NMOD + 5 * D, nullptr, nullptr, nullptr, rgsv + 2 * 8 * D};
        pg8::StaticOrder S; S.init(M, D, gridDim.x, blockIdx.x);
        pg8::gemm_phase<EpiT, pg8::StaticOrder, true, true>(glds, g, S, E);
    } else if constexpr (PH == 7 || PH == 14) {
        pg8::Gemm g{H, (const bf16_t*)(a.ws + (PH == 7 ? WS_WGU0 : WS_WGU1)), M, NGU, D};
        pg8::EpiSwiGLU E{BIG, rowss + (size_t)(PH == 7 ? 0 : 2) * M, cvec + (PH == 7 ? CV_GU0 : CV_GU1)};
        pg8::StaticOrder S; S.init(M, NGU, gridDim.x, blockIdx.x);
        pg8::gemm_phase<pg8::EpiSwiGLU, pg8::StaticOrder, true, true>(glds, g, S, E);
    } else if constexpr (PH == 11) {
        attn_phase(a, lds);
    }
}
__global__ void __launch_bounds__(512, 2) fwd_megakernel(Args a) {
    extern __shared__ __attribute__((aligned(16))) unsigned char lds[];
    volatile LAS unsigned* misc = (volatile LAS unsigned*)((LAS unsigned char*)lds + MISC_OFF);
    XcdBarrier xbar; xbar.bar = (unsigned*)(a.ws + WS_BAR); xbar.x = 0; xbar.st = misc;
    if (a.coop) {
        if (threadIdx.x < 2) misc[threadIdx.x] = 0u;
        __syncthreads();
        xbar = xcd_barrier_post((unsigned*)(a.ws + WS_BAR), misc);
    }
#ifndef DUP_MASK
#define DUP_MASK 0
#endif
    if (a.pad) cg::this_grid().sync();
#define SEAM(k) xcd_barrier(xbar)
#define PHASE(k) if (EN(k) && a.ph_lo <= (k) && (k) < a.ph_hi) { if ((DUP_MASK >> (k)) & 1) { run_phase<k, true>(a, lds); SEAM(k); } run_phase<k>(a, lds); if ((k) + 1 < a.ph_hi && a.coop) SEAM(k); }
    PHASE(0) PHASE(1) PHASE(2) PHASE(3) PHASE(5) PHASE(7) PHASE(8) PHASE(10) PHASE(11) PHASE(12) PHASE(14) PHASE(15)
#undef PHASE
#undef SEAM
}

extern "C" void kernel_launch(void* const* d_in, const int* in_sizes, int n_in, void* d_out, int out_size, void* d_ws, size_t ws_size, hipStream_t stream) {
    static int grid = 0;
    if (grid == 0) {
        if (n_in != 30 || out_size != M * D || ws_size < WS_END) { fprintf(stderr, "kernel_launch: unexpected shapes (n_in %d out %d ws %zu)\n", n_in, out_size, ws_size); grid = -1; return; }
        int dev = 0, cus = 0, per_cu = 0;
        (void)hipGetDevice(&dev); (void)hipDeviceGetAttribute(&cus, hipDeviceAttributeMultiprocessorCount, dev);
        if (hipFuncSetAttribute((const void*)fwd_megakernel, hipFuncAttributeMaxDynamicSharedMemorySize, LDS_BYTES) != hipSuccess) { fprintf(stderr, "kernel_launch: hipFuncSetAttribute failed\n"); grid = -1; return; }
        if (hipOccupancyMaxActiveBlocksPerMultiprocessor(&per_cu, (const void*)fwd_megakernel, 512, LDS_BYTES) != hipSuccess || per_cu < 1) { fprintf(stderr, "kernel_launch: occupancy query gave %d\n", per_cu); per_cu = 1; }
        (void)hipGetLastError();
        if (cus < 256) { fprintf(stderr, "kernel_launch: needs 256 CUs (found %d)\n", cus); grid = -1; return; }
        grid = 256;
    }
    if (grid < 0) return;
    Args a{};
    for (int i = 0; i < 30; ++i) a.in[i] = (const float*)d_in[i];
    a.out = (float*)d_out; a.ws = (unsigned char*)d_ws;
#if MK_ONE_LAUNCH
    a.ph_lo = 0; a.ph_hi = NPHASE; a.coop = 1;
    if (hipMemsetAsync((char*)d_ws + WS_BAR, 0, XCD_BAR_WORDS * 4 + 64 * 16 * 4, stream) != hipSuccess) { fprintf(stderr, "kernel_launch: memset of the barrier words failed\n"); return; }
    void* args[] = {&a};
    hipError_t e = hipLaunchCooperativeKernel((const void*)fwd_megakernel, dim3(grid), dim3(512), args, LDS_BYTES, stream);
    if (e != hipSuccess) fprintf(stderr, "cooperative launch failed: %s (grid %d)\n", hipGetErrorString(e), grid);
#else
    for (int ph = 0; ph < NPHASE; ++ph) {
        a.ph_lo = ph; a.ph_hi = ph + 1; a.coop = 0;
        hipLaunchKernelGGL(fwd_megakernel, dim3(grid), dim3(512), LDS_BYTES, stream, a);
    }
#endif
}
```
